# Optimizing an MI355X kernel written in HIP

```python
import jax, jax.numpy as jnp
from jax import lax
import numpy as np

D_MODEL = 1024
BATCH = 16
SEQ = 2048
DEPTH = 1

CTX_LEN = 256
GRID_W = 64

RW_WIDTH = 512
RW_HEAD = 64
RW_HEADS = RW_WIDTH // RW_HEAD
RW_DECAY_LORA = 32
RW_ICLR_LORA = 32
RW_GATE_LORA = 96
RW_GN_EPS = 64e-5
GLA_HEADS = 4
GLA_DK = 64
GLA_DV = 128
GLA_KEY = GLA_HEADS * GLA_DK
GLA_VAL = GLA_HEADS * GLA_DV
GLA_GATE_LORA = 16
GLA_GATE_NORM = 16.0
GLA_CHUNK = 64
GLA_NORM_EPS = 1e-5
MIX_WIDTH = RW_WIDTH + GLA_VAL

RW_SIZES = (RW_WIDTH, RW_WIDTH, RW_WIDTH, RW_DECAY_LORA, RW_DECAY_LORA,
            RW_ICLR_LORA, RW_ICLR_LORA, RW_GATE_LORA)
RW_IN = 3 * RW_WIDTH + 2 * RW_DECAY_LORA + 2 * RW_ICLR_LORA + RW_GATE_LORA
GLA_SIZES = (GLA_KEY, GLA_KEY, GLA_VAL, GLA_VAL, GLA_GATE_LORA, GLA_GATE_LORA)
GLA_IN = 2 * GLA_KEY + 2 * GLA_VAL + 2 * GLA_GATE_LORA
IN_WIDTH = RW_IN + GLA_IN

N_EXPERTS = 16
EXPERT_FF = 2816
CAPACITY_FACTOR = 2

DN_ALPHA = (2 * DEPTH) ** 0.25
DN_BETA = (8 * DEPTH) ** -0.25
LN_EPS = 1e-5

kernel_name = 'hymba_rwkv7_gla_ecmoe_diffusion_block'


def split_cols(z, sizes):
    offsets = []
    acc = 0
    for s in sizes[:-1]:
        acc += s
        offsets.append(acc)
    return jnp.split(z, offsets, axis=-1)


def ln_plain(x):
    xf = x.astype(jnp.float32)
    mu = jnp.mean(xf, -1, keepdims=True)
    var = jnp.mean(jnp.square(xf - mu), -1, keepdims=True)
    return ((xf - mu) * lax.rsqrt(var + LN_EPS)).astype(x.dtype)


def ln_affine(x, g, b):
    return ln_plain(x) * g + b


def modulate(h, shift, scale):
    return h * (1.0 + scale) + shift


def seq_shift_delta(z):
    zp = jnp.pad(z, ((0, 0), (1, 1), (0, 0)))
    return 0.5 * (zp[:, :-2] + zp[:, 2:]) - z


def grid_shift_delta(z):
    B, T, F = z.shape
    rows = T // GRID_W
    g = z.reshape(B, rows, GRID_W, F)
    gp = jnp.pad(g, ((0, 0), (1, 1), (1, 1), (0, 0)))
    nb = 0.25 * (gp[:, :-2, 1:-1] + gp[:, 2:, 1:-1] + gp[:, 1:-1, :-2] + gp[:, 1:-1, 2:])
    return nb.reshape(B, T, F) - z


def wkv7_scan(r, decay, kk, kka, k, v, s0, reverse):
    def step(s, inp):
        r_t, w_t, kk_t, kka_t, k_t, v_t = inp
        s_kk = jnp.einsum('bhvk,bhk->bhv', s, kk_t)
        s = s * w_t[:, :, None, :] - s_kk[..., None] * kka_t[:, :, None, :] + v_t[..., None] * k_t[:, :, None, :]
        y = jnp.einsum('bhvk,bhk->bhv', s, r_t)
        return s, y
    xs = tuple(jnp.moveaxis(t.astype(jnp.float32), 1, 0) for t in (r, decay, kk, kka, k, v))
    s, ys = lax.scan(step, s0, xs, reverse=reverse)
    return jnp.moveaxis(ys, 0, 1), s


def rwkv_direction(r_h, k, v_h, kk, wd, ad, w0, w2, a0, a2, k_a, r_k, s0, reverse):
    B, T = k.shape[:2]
    heads = lambda t: t.reshape(B, T, RW_HEADS, RW_HEAD)
    w_log = -jax.nn.softplus(-(w0 + jnp.tanh(wd) @ w2)) - 0.5
    decay = jnp.exp(-jnp.exp(w_log.astype(jnp.float32)))
    a = jax.nn.sigmoid(a0 + ad @ a2)
    k_h = heads(k * (1.0 + (a - 1.0) * k_a))
    y, s = wkv7_scan(r_h, heads(decay), kk, kk * heads(a), k_h, v_h, s0, reverse)
    bonus = jnp.sum(r_h * k_h * r_k, -1, keepdims=True) * v_h
    return y, bonus, s


def gla_chunked(q, k, v, log_a, s0):
    B, T, H, K = q.shape
    V = v.shape[-1]
    C = GLA_CHUNK
    n = T // C
    f32 = jnp.float32
    q = q.astype(f32).reshape(B, n, C, H, K)
    k = k.astype(f32).reshape(B, n, C, H, K)
    v = v.astype(f32).reshape(B, n, C, H, V)
    b = jnp.cumsum(log_a.astype(f32).reshape(B, n, C, H, K), axis=2)
    b_last = b[:, :, -1]
    q_in = q * jnp.exp(b)
    k_in = k * jnp.exp(-b)
    k_out = k * jnp.exp(b_last[:, :, None] - b)
    scores = jnp.einsum('bnihk,bnjhk->bnhij', q_in, k_in)
    mask = jnp.tril(jnp.ones((C, C), dtype=bool))
    scores = jnp.where(mask, scores, 0.0)
    o_intra = jnp.einsum('bnhij,bnjhv->bnihv', scores, v)
    d_state = jnp.einsum('bnjhk,bnjhv->bnhkv', k_out, v)

    def step(s, inp):
        ds_c, bl = inp
        return s * jnp.exp(bl)[..., None] + ds_c, s

    s_final, s_starts = lax.scan(step, s0, (jnp.moveaxis(d_state, 1, 0), jnp.moveaxis(b_last, 1, 0)))
    s_starts = jnp.moveaxis(s_starts, 0, 1)
    o_inter = jnp.einsum('bnihk,bnhkv->bnihv', q_in, s_starts)
    return (o_intra + o_inter).reshape(B, T, H, V), s_final


def mix_tokens(h, delta_fn, p, states0):
    B, T, _ = h.shape
    proj = jnp.einsum('btd,df->btf', h, p['w_in'])
    z_rw, z_gla = proj[..., :RW_IN], proj[..., RW_IN:]

    z_rw = z_rw + delta_fn(z_rw) * p['rw_mu']
    r, k, v, wd_f, wd_b, ad_f, ad_b, gd = split_cols(z_rw, RW_SIZES)
    heads = lambda t: t.reshape(B, T, RW_HEADS, RW_HEAD)
    r_h, v_h = heads(r), heads(v)
    kk = heads(k * p['rw_k_k']).astype(jnp.float32)
    kk = kk * lax.rsqrt(jnp.sum(kk * kk, -1, keepdims=True) + 1e-12)
    g_out = jax.nn.sigmoid(gd) @ p['rw_g2']
    y_f, bo_f, s_rw_f = rwkv_direction(r_h, k, v_h, kk, wd_f, ad_f, p['rw_w0'][0], p['rw_w2'][0],
                                       p['rw_a0'][0], p['rw_a2'][0], p['rw_k_a'], p['rw_r_k'],
                                       states0[0], False)
    y_b, bo_b, s_rw_b = rwkv_direction(r_h, k, v_h, kk, wd_b, ad_b, p['rw_w0'][1], p['rw_w2'][1],
                                       p['rw_a0'][1], p['rw_a2'][1], p['rw_k_a'], p['rw_r_k'],
                                       states0[1], True)
    y = y_f + y_b
    mu = jnp.mean(y, -1, keepdims=True)
    var = jnp.mean(jnp.square(y - mu), -1, keepdims=True)
    y_n = ((y - mu) * lax.rsqrt(var + RW_GN_EPS)).reshape(B, T, RW_WIDTH) * p['rw_gn_w'] + p['rw_gn_b']
    rw_out = (y_n + (bo_f + bo_b).reshape(B, T, RW_WIDTH)) * g_out

    q, kg, vg, gg, gad_f, gad_b = split_cols(z_gla, GLA_SIZES)
    q_h = q.reshape(B, T, GLA_HEADS, GLA_DK) * (GLA_DK ** -0.5)
    k_g = kg.reshape(B, T, GLA_HEADS, GLA_DK)
    v_g = vg.reshape(B, T, GLA_HEADS, GLA_DV)
    la_f = (jax.nn.log_sigmoid((gad_f @ p['gla_a2'][0] + p['gla_a_b'][0]).astype(jnp.float32))
            / GLA_GATE_NORM).reshape(B, T, GLA_HEADS, GLA_DK)
    la_b = (jax.nn.log_sigmoid((gad_b @ p['gla_a2'][1] + p['gla_a_b'][1]).astype(jnp.float32))
            / GLA_GATE_NORM).reshape(B, T, GLA_HEADS, GLA_DK)
    o_f, s_gla_f = gla_chunked(q_h, k_g, v_g, la_f, states0[2])
    flip = lambda t: jnp.flip(t, axis=1)
    o_b, s_gla_b = gla_chunked(flip(q_h), flip(k_g), flip(v_g), flip(la_b), states0[3])
    o = o_f + flip(o_b)
    o = o * lax.rsqrt(jnp.mean(jnp.square(o), -1, keepdims=True) + GLA_NORM_EPS)
    gla_out = o.reshape(B, T, GLA_VAL) * p['gla_norm_w'] * jax.nn.silu(gg)

    return jnp.concatenate([rw_out, gla_out], axis=-1), (s_rw_f, s_rw_b, s_gla_f, s_gla_b)


def expert_choice_ffn(h, router_w, w_gate, w_up, w_down):
    B, T, D = h.shape
    cap = CAPACITY_FACTOR * T // N_EXPERTS
    logits = jnp.einsum('btd,de->bte', h, router_w).astype(jnp.float32)
    aff = jax.nn.softmax(logits, axis=-1)
    gates, idx = lax.top_k(jnp.swapaxes(aff, 1, 2), cap)
    xin = jax.vmap(lambda hb, ib: hb[ib])(h, idx)

    def expert(args):
        xe, wg, wu, wd = args
        return (jax.nn.silu(xe @ wg) * (xe @ wu)) @ wd

    ye = lax.map(expert, (jnp.swapaxes(xin, 0, 1), w_gate, w_up, w_down))
    ye = jnp.swapaxes(ye, 0, 1) * gates[..., None]
    out = jnp.zeros(h.shape, ye.dtype)
    return out.at[jnp.arange(B)[:, None, None], idx].add(ye)


def setup_inputs(seed: int = 0) -> dict:
    key = jax.random.key(seed)
    ks = jax.random.split(key, 30)
    f32 = jnp.float32
    nrm = lambda i, shape, s: s * jax.random.normal(ks[i], shape, f32)
    L, D, E, F = DEPTH, D_MODEL, N_EXPERTS, EXPERT_FF
    return {
        'x': nrm(0, (BATCH, SEQ, D), 1.0),
        'c': nrm(1, (BATCH, D), 1.0),
        'ctx': nrm(2, (BATCH, CTX_LEN, D), 1.0),
        'c_ctx': nrm(3, (D,), 1.0),
        'ada_w': nrm(4, (L, D, 6 * D), D ** -0.5),
        'ada_b': nrm(5, (L, 6 * D), 0.02),
        'w_in': nrm(6, (L, D, IN_WIDTH), D ** -0.5),
        'rw_mu': jax.random.uniform(ks[7], (L, RW_IN), f32),
        'rw_w0': jax.random.uniform(ks[8], (L, 2, RW_WIDTH), f32, -6.5, -1.5),
        'rw_w2': nrm(9, (L, 2, RW_DECAY_LORA, RW_WIDTH), 0.5 * RW_DECAY_LORA ** -0.5),
        'rw_a0': nrm(10, (L, 2, RW_WIDTH), 0.3),
        'rw_a2': nrm(11, (L, 2, RW_ICLR_LORA, RW_WIDTH), 0.5 * RW_ICLR_LORA ** -0.5),
        'rw_g2': nrm(12, (L, RW_GATE_LORA, RW_WIDTH), RW_GATE_LORA ** -0.5),
        'rw_k_k': 0.85 + nrm(13, (L, RW_WIDTH), 0.05),
        'rw_k_a': 1.0 + nrm(14, (L, RW_WIDTH), 0.05),
        'rw_r_k': nrm(15, (L, RW_HEADS, RW_HEAD), 0.1),
        'rw_gn_w': 1.0 + nrm(16, (L, RW_WIDTH), 0.05),
        'rw_gn_b': nrm(17, (L, RW_WIDTH), 0.02),
        'gla_a2': nrm(18, (L, 2, GLA_GATE_LORA, GLA_KEY), GLA_GATE_LORA ** -0.5),
        'gla_a_b': 1.0 + nrm(19, (L, 2, GLA_KEY), 0.5),
        'gla_norm_w': 1.0 + nrm(20, (L, GLA_VAL), 0.05),
        'w_out': nrm(21, (L, MIX_WIDTH, D), DN_BETA * MIX_WIDTH ** -0.5),
        'ln1_g': 1.0 + nrm(22, (L, D), 0.05),
        'ln1_b': nrm(23, (L, D), 0.02),
        'router_w': nrm(24, (L, D, E), D ** -0.5),
        'ex_gate': nrm(25, (L, E, D, F), D ** -0.5),
        'ex_up': nrm(26, (L, E, D, F), D ** -0.5),
        'ex_down': nrm(27, (L, E, F, D), DN_BETA * F ** -0.5),
        'ln2_g': 1.0 + nrm(28, (L, D), 0.05),
        'ln2_b': nrm(29, (L, D), 0.02),
    }


def reference(x, c, ctx, c_ctx, ada_w, ada_b, w_in, rw_mu, rw_w0, rw_w2, rw_a0, rw_a2, rw_g2,
              rw_k_k, rw_k_a, rw_r_k, rw_gn_w, rw_gn_b, gla_a2, gla_a_b, gla_norm_w, w_out,
              ln1_g, ln1_b, router_w, ex_gate, ex_up, ex_down, ln2_g, ln2_b):
    B = x.shape[0]
    f32 = jnp.float32
    zero_states = (jnp.zeros((B, RW_HEADS, RW_HEAD, RW_HEAD), f32),
                   jnp.zeros((B, RW_HEADS, RW_HEAD, RW_HEAD), f32),
                   jnp.zeros((B, GLA_HEADS, GLA_DK, GLA_DV), f32),
                   jnp.zeros((B, GLA_HEADS, GLA_DK, GLA_DV), f32))
    silu_c = jax.nn.silu(c)
    silu_cc = jax.nn.silu(c_ctx)
    for layer in range(DEPTH):
        last = layer == DEPTH - 1
        p = dict(w_in=w_in[layer], rw_mu=rw_mu[layer], rw_w0=rw_w0[layer], rw_w2=rw_w2[layer],
                 rw_a0=rw_a0[layer], rw_a2=rw_a2[layer], rw_g2=rw_g2[layer], rw_k_k=rw_k_k[layer],
                 rw_k_a=rw_k_a[layer], rw_r_k=rw_r_k[layer], rw_gn_w=rw_gn_w[layer],
                 rw_gn_b=rw_gn_b[layer], gla_a2=gla_a2[layer], gla_a_b=gla_a_b[layer],
                 gla_norm_w=gla_norm_w[layer])
        mod = (silu_c @ ada_w[layer] + ada_b[layer])[:, None, :]
        mod_c = silu_cc @ ada_w[layer] + ada_b[layer]
        sh1, sc1, g1, sh2, sc2, g2 = jnp.split(mod, 6, axis=-1)
        sh1c, sc1c, g1c, sh2c, sc2c, g2c = jnp.split(mod_c, 6, axis=-1)

        h_ctx = modulate(ln_plain(ctx), sh1c, sc1c)
        h_lat = modulate(ln_plain(x), sh1, sc1)
        o_ctx, ctx_states = mix_tokens(h_ctx, seq_shift_delta, p, zero_states)
        o_lat, _ = mix_tokens(h_lat, grid_shift_delta, p, ctx_states)
        x = ln_affine(DN_ALPHA * x + g1 * (o_lat @ w_out[layer]), ln1_g[layer], ln1_b[layer])

        h2 = modulate(ln_plain(x), sh2, sc2)
        moe = expert_choice_ffn(h2, router_w[layer], ex_gate[layer], ex_up[layer], ex_down[layer])
        x = ln_affine(DN_ALPHA * x + g2 * moe, ln2_g[layer], ln2_b[layer])

        if not last:
            ctx = ln_affine(DN_ALPHA * ctx + g1c * (o_ctx @ w_out[layer]), ln1_g[layer], ln1_b[layer])
            h2c = modulate(ln_plain(ctx), sh2c, sc2c)
            moe_c = expert_choice_ffn(h2c, router_w[layer], ex_gate[layer], ex_up[layer], ex_down[layer])
            ctx = ln_affine(DN_ALPHA * ctx + g2c * moe_c, ln2_g[layer], ln2_b[layer])
    return x
```

```cpp
#include <hip/hip_runtime.h>
#include <cstdio>
#include <cstdint>

namespace pg8 {
#define PG8_LAS __attribute__((address_space(3)))
typedef unsigned short bf16_t;
typedef short bf16x8 __attribute__((ext_vector_type(8)));
typedef float f32x4 __attribute__((ext_vector_type(4)));
typedef unsigned u32x4 __attribute__((ext_vector_type(4)));
typedef unsigned u32x2 __attribute__((ext_vector_type(2)));
typedef int i32x4 __attribute__((ext_vector_type(4)));
typedef int i32x8 __attribute__((ext_vector_type(8)));
constexpr int BM = 256, BK = 64, HALF = 128, HTB = HALF * BK * 2  , STAGE_BYTES = 8 * HTB, NXCD = 8, WGM = 8;

__host__ __device__ __forceinline__ int lds_byte(int r, int c) { const int st = (r >> 4) * 2 + (c >> 5), rr = r & 15, cc = c & 31, ob = rr * 64 + cc * 2; return st * 1024 + (ob ^ (((ob >> 9) & 1) << 5)); }
__host__ __device__ __forceinline__ void stage_rc(int b, int& R, int& C) { const int st = b / 1024, sb = b % 1024, swz = sb ^ (((sb >> 9) & 1) << 5); R = (st >> 1) * 16 + swz / 64; C = (st & 1) * 32 + (swz % 64) / 2; }
__host__ __device__ __forceinline__ int perm32(int rho) { const int n = rho >> 4, i = rho & 15; return 8 * (i >> 2) + 4 * n + (i & 3); }

struct Unit { int pm, pn, pb; };
struct Gemm { const bf16_t* A; const bf16_t* Bt; int M, N, K; };

struct StaticOrder {
    int nM, nN, nwg, G, c, grp, bbase;
    __host__ __device__ void init(int M, int N, int G_, int c_, int grp_ = 0, int bbase_ = 0) { nM = M / BM; nN = N / BM; nwg = nM * nN; G = G_; c = c_; grp = grp_; bbase = bbase_; }
    __host__ __device__ bool next(int i, Unit& u) const {
        const long L = (long)i * G + c; if (L >= nwg) return false;
        int wgid = (int)L; { const int q = nwg / NXCD, r = nwg % NXCD, xcd = wgid % NXCD, off = wgid / NXCD; wgid = (xcd < r ? xcd * (q + 1) : r * (q + 1) + (xcd - r) * q) + off; }
        const int nig = WGM * nN, gid = wgid / nig, fm = gid * WGM, gsz = (nM - fm) < WGM ? (nM - fm) : WGM;
        u.pm = fm + ((wgid % nig) % gsz); u.pn = (wgid % nig) / gsz; u.pb = bbase + (grp ? (u.pm / grp) * nN : 0) + u.pn; return true;
    }
};

struct InProjOrder {
    StaticOrder lat; int nlat, nctx_n, first_ctx_pm, skip_n, ntot, G, c;
    __host__ __device__ void init(int lat_rows, int ctx_rows, int N, int skip_n_, int G_, int c_) { lat.init(lat_rows, N, G_, c_); nlat = lat.nwg; skip_n = skip_n_; nctx_n = N / BM - skip_n_; first_ctx_pm = lat_rows / BM; ntot = nlat + (ctx_rows / BM) * nctx_n; G = G_; c = c_; }
    __host__ __device__ bool next(int i, Unit& u) const {
        const long L = (long)i * G + c; if (L >= ntot) return false;
        if (L < nlat) { StaticOrder t = lat; t.G = G; t.c = c; return t.next(i, u); }
        const int j = (int)L - nlat; u.pm = first_ctx_pm + j / nctx_n; u.pn = skip_n + j % nctx_n; u.pb = u.pn; return true;
    }
};

__device__ __forceinline__ unsigned cvt_pk_bf16(float lo, float hi) { unsigned r; asm volatile("v_cvt_pk_bf16_f32 %0, %1, %2" : "=v"(r) : "v"(lo), "v"(hi)); return r; }

struct EpiF32 {
    static constexpr bool PERM = false; static constexpr int WSCALE = 0x7f7f7f7f;
    float* C; int ldc;
    __device__ __forceinline__ void operator()(const f32x4 (&acc)[2][2][4][2], const Unit& u, int wr, int wc, int fr, int fq) const {
        const int row0 = u.pm * BM + wr * 64 + fr, col0 = u.pn * BM + wc * 32 + 4 * fq;
#pragma unroll
        for (int ai = 0; ai < 2; ++ai)
#pragma unroll
            for (int m = 0; m < 4; ++m) { float* rowp = C + (size_t)(row0 + ai * HALF + m * 16) * ldc + col0;
#pragma unroll
                for (int bj = 0; bj < 2; ++bj)
#pragma unroll
                    for (int n = 0; n < 2; ++n) *(f32x4*)(rowp + bj * HALF + n * 16) = acc[ai][bj][m][n]; }
    }
};
struct EpiBf16 {
    static constexpr bool PERM = true; static constexpr int WSCALE = 0x7f7f7f7f;
    bf16_t* O; int ldc; float scale;
    __device__ __forceinline__ void operator()(const f32x4 (&acc)[2][2][4][2], const Unit& u, int wr, int wc, int fr, int fq) const {
        const int row0 = u.pm * BM + wr * 64 + fr, col0 = u.pn * BM + wc * 32 + 8 * fq;
#pragma unroll
        for (int ai = 0; ai < 2; ++ai)
#pragma unroll
            for (int m = 0; m < 4; ++m) { bf16_t* rowp = O + (size_t)(row0 + ai * HALF + m * 16) * ldc + col0;
#pragma unroll
                for (int bj = 0; bj < 2; ++bj) { const f32x4 v0 = acc[ai][bj][m][0] * scale, v1 = acc[ai][bj][m][1] * scale;
                    u32x4 w; w.x = cvt_pk_bf16(v0[0], v0[1]); w.y = cvt_pk_bf16(v0[2], v0[3]); w.z = cvt_pk_bf16(v1[0], v1[1]); w.w = cvt_pk_bf16(v1[2], v1[3]);
                    *(u32x4*)(rowp + bj * HALF) = w; } }
    }
};
struct EpiSwiGLU {
    static constexpr bool PERM = true; static constexpr int WSCALE = 0x7f7f7f7f;
    bf16_t* H; int ldh;
    __device__ __forceinline__ void operator()(const f32x4 (&acc)[2][2][4][2], const Unit& u, int wr, int wc, int fr, int fq) const {
        const int row0 = u.pm * BM + wr * 64 + fr, col0 = u.pn * HALF + wc * 32 + 8 * fq;
#pragma unroll
        for (int ai = 0; ai < 2; ++ai)
#pragma unroll
            for (int m = 0; m < 4; ++m) { bf16_t* rowp = H + (size_t)(row0 + ai * HALF + m * 16) * ldh + col0;
                float h[8];
#pragma unroll
                for (int n = 0; n < 2; ++n)
#pragma unroll
                    for (int j = 0; j < 4; ++j) { const float g = acc[ai][0][m][n][j], up = acc[ai][1][m][n][j]; h[n * 4 + j] = g * up * __builtin_amdgcn_rcpf(1.0f + __expf(-g)); }
                u32x4 w; w.x = cvt_pk_bf16(h[0], h[1]); w.y = cvt_pk_bf16(h[2], h[3]); w.z = cvt_pk_bf16(h[4], h[5]); w.w = cvt_pk_bf16(h[6], h[7]);
                *(u32x4*)rowp = w; }
    }
};

struct EpiF8 {
    static constexpr bool PERM = true; static constexpr int WSCALE = 0x7f7f7f7f;
    unsigned char* O; int ldc; float scale;
    __device__ __forceinline__ void operator()(const f32x4 (&acc)[2][2][4][2], const Unit& u, int wr, int wc, int fr, int fq) const {
        const int row0 = u.pm * BM + wr * 64 + fr, col0 = u.pn * BM + wc * 32 + 8 * fq;
#pragma unroll
        for (int ai = 0; ai < 2; ++ai)
#pragma unroll
            for (int m = 0; m < 4; ++m) { unsigned char* rowp = O + (size_t)(row0 + ai * HALF + m * 16) * ldc + col0;
#pragma unroll
                for (int bj = 0; bj < 2; ++bj) { const f32x4 v0 = acc[ai][bj][m][0] * scale, v1 = acc[ai][bj][m][1] * scale;
                    unsigned w0 = __builtin_amdgcn_cvt_pk_fp8_f32(__builtin_amdgcn_fmed3f(v0[0], -448.f, 448.f), __builtin_amdgcn_fmed3f(v0[1], -448.f, 448.f), 0, false);
                    w0 = __builtin_amdgcn_cvt_pk_fp8_f32(__builtin_amdgcn_fmed3f(v0[2], -448.f, 448.f), __builtin_amdgcn_fmed3f(v0[3], -448.f, 448.f), w0, true);
                    unsigned w1 = __builtin_amdgcn_cvt_pk_fp8_f32(__builtin_amdgcn_fmed3f(v1[0], -448.f, 448.f), __builtin_amdgcn_fmed3f(v1[1], -448.f, 448.f), 0, false);
                    w1 = __builtin_amdgcn_cvt_pk_fp8_f32(__builtin_amdgcn_fmed3f(v1[2], -448.f, 448.f), __builtin_amdgcn_fmed3f(v1[3], -448.f, 448.f), w1, true);
                    *(u32x2*)(rowp + bj * HALF) = (u32x2){w0, w1}; } }
    }
};
__device__ __forceinline__ float clamp448(float x) { return __builtin_amdgcn_fmed3f(x, -448.0f, 448.0f); }
struct EpiSwiGLU8 {
    static constexpr bool PERM = true; static constexpr int WSCALE = 0x7a7a7a7a;
    unsigned char* H; int ldh; float in_scale, out_scale;
    __device__ __forceinline__ void operator()(const f32x4 (&acc)[2][2][4][2], const Unit& u, int wr, int wc, int fr, int fq) const {
        const int row0 = u.pm * BM + wr * 64 + fr, col0 = u.pn * HALF + wc * 32 + 8 * fq;
#pragma unroll
        for (int ai = 0; ai < 2; ++ai)
#pragma unroll
            for (int m = 0; m < 4; ++m) { unsigned char* rowp = H + (size_t)(row0 + ai * HALF + m * 16) * ldh + col0;
                float h[8];
#pragma unroll
                for (int n = 0; n < 2; ++n)
#pragma unroll
                    for (int j = 0; j < 4; ++j) { const float ga = acc[ai][0][m][n][j], ua = acc[ai][1][m][n][j];
                        const float sg = __builtin_amdgcn_rcpf(1.0f + __builtin_amdgcn_exp2f(-ga));
                        h[n * 4 + j] = clamp448(ga * ua * sg); }
                unsigned w0 = __builtin_amdgcn_cvt_pk_fp8_f32(h[0], h[1], 0, false); w0 = __builtin_amdgcn_cvt_pk_fp8_f32(h[2], h[3], w0, true);
                unsigned w1 = __builtin_amdgcn_cvt_pk_fp8_f32(h[4], h[5], 0, false); w1 = __builtin_amdgcn_cvt_pk_fp8_f32(h[6], h[7], w1, true);
                *(u32x2*)rowp = (u32x2){w0, w1}; }
    }
};

#ifndef F8_SCALE_WORD
#define F8_SCALE_WORD 0x7f7f7f7f
#endif
template <bool F8> struct FragT;
struct Frag16 { bf16x8 k[2]; };
template <> struct FragT<false> { typedef Frag16 T; };
template <> struct FragT<true> { typedef i32x8 T; };
__device__ __forceinline__ void frag_load(Frag16& d, const PG8_LAS unsigned char* p) { d.k[0] = *(const PG8_LAS bf16x8*)p; d.k[1] = *(const PG8_LAS bf16x8*)(p + 1024); }
__device__ __forceinline__ void frag_load(i32x8& d, const PG8_LAS unsigned char* p) { const i32x4 lo = *(const PG8_LAS i32x4*)p, hi = *(const PG8_LAS i32x4*)(p + 16); d = __builtin_shufflevector(lo, hi, 0, 1, 2, 3, 4, 5, 6, 7); }
template <int WSC> __device__ __forceinline__ f32x4 frag_mma(const Frag16& b, const Frag16& a, f32x4 c) { c = __builtin_amdgcn_mfma_f32_16x16x32_bf16(b.k[0], a.k[0], c, 0, 0, 0); return __builtin_amdgcn_mfma_f32_16x16x32_bf16(b.k[1], a.k[1], c, 0, 0, 0); }
template <int WSC> __device__ __forceinline__ f32x4 frag_mma(const i32x8& b, const i32x8& a, f32x4 c) {
#if F8_SCALE_WORD
    const int sc = F8_SCALE_WORD, scw = WSC; asm volatile("v_mfma_scale_f32_16x16x128_f8f6f4 %0, %1, %2, %0, %3, %4 op_sel_hi:[0,0,0]" : "+v"(c) : "v"(b), "v"(a), "v"(scw), "v"(sc));
#else
    asm volatile("v_mfma_f32_16x16x128_f8f6f4 %0, %1, %2, %0" : "+v"(c) : "v"(b), "v"(a));
#endif
    return c; }
#ifndef PG8_SP2
#define PG8_SP2 false
#endif
template <class Epi, class Sched, bool F8 = false, bool ALIGN_EPI = true, bool SP2 = PG8_SP2>
__device__ __forceinline__ void gemm_phase(PG8_LAS unsigned char* lds, const Gemm g, const Sched& S, const Epi& E) {
    int tid_ = threadIdx.x; asm volatile("" : "+v"(tid_));
    const int tid = tid_, wid = __builtin_amdgcn_readfirstlane(tid >> 6), lane = tid & 63, wr = wid >> 2, wc = wid & 3, fr = lane & 15, fq = lane >> 4;
    const int K = g.K, rowb = F8 ? K : 2 * K, nt = rowb / 128;
    unsigned voffA[2], voffB[2];
#pragma unroll
    for (int i = 0; i < 2; ++i) { int R, C; stage_rc(tid * 16 + i * 8192, R, C); const int Rb = Epi::PERM ? ((R & ~31) + perm32(R & 31)) : R;
        voffA[i] = (unsigned)(R * rowb + C * 2); voffB[i] = (unsigned)(Rb * rowb + C * 2); }
    const size_t kstep = (size_t)(BK * 2);
    const size_t hstep = (size_t)HALF * rowb;
    const size_t tstep = 2 * hstep;
    const unsigned ldsw = (unsigned)wid * 1024u;
    const int aoff = lds_byte(wr * 64 + fr, fq * (F8 ? 16 : 8)), boff = lds_byte(wc * 32 + fr, fq * (F8 ? 16 : 8));
#define PG8_SA(b, h) (((b) * 2 + (h)) * HTB)
#define PG8_SB(b, h) ((4 + (b) * 2 + (h)) * HTB)
#define PG8_STAGE(bufoff, gbase, voff) do { _Pragma("unroll") for (int _i = 0; _i < 2; ++_i) \
        __builtin_amdgcn_global_load_lds((const unsigned*)((const char*)(gbase) + (voff)[_i]), (PG8_LAS unsigned*)(lds + (bufoff) + ldsw + _i * 8192), 16, 0, 0); } while (0)
#define PG8_LDA(dst, b, h) do { _Pragma("unroll") for (int m = 0; m < 4; ++m) frag_load(dst[m], lds + PG8_SA(b, h) + aoff + m * 2048); } while (0)
#define PG8_LDB(dst, b, h) do { _Pragma("unroll") for (int n = 0; n < 2; ++n) frag_load(dst[n], lds + PG8_SB(b, h) + boff + n * 2048); } while (0)
#define PG8_MMA(ai, bj, At, Bt) do { __builtin_amdgcn_s_setprio(1); _Pragma("unroll") for (int m = 0; m < 4; ++m) _Pragma("unroll") for (int n = 0; n < 2; ++n) \
        acc[ai][bj][m][n] = frag_mma<Epi::WSCALE>(Bt[n], At[m], acc[ai][bj][m][n]); __builtin_amdgcn_s_setprio(0); } while (0)
#define PG8_WAIT_V(n) asm volatile("s_waitcnt vmcnt(" #n ")" ::: "memory")
#define PG8_WAIT_L(n) asm volatile("s_waitcnt lgkmcnt(" #n ")" ::: "memory")
#define PG8_BAR __builtin_amdgcn_s_barrier()
#define PG8_SCHED __builtin_amdgcn_sched_barrier(0)
    Unit cur, nxt; int ui = 0;
    if (!S.next(0, cur)) return;
    f32x4 acc[2][2][4][2];
#pragma unroll
    for (int a = 0; a < 2; ++a)
#pragma unroll
        for (int b = 0; b < 2; ++b)
#pragma unroll
            for (int m = 0; m < 4; ++m)
#pragma unroll
                for (int n = 0; n < 2; ++n) { acc[a][b][m][n] = (f32x4){0.f, 0.f, 0.f, 0.f}; if (F8) asm volatile("" : "+v"(acc[a][b][m][n])); }
    typename FragT<F8>::T At[4], B0[2], B1[2];
    const char* cA = (const char*)g.A + (size_t)cur.pm * tstep; const char* cB = (const char*)g.Bt + (size_t)cur.pb * tstep;
    if constexpr (SP2) {
        PG8_STAGE(PG8_SB(0, 0), cB, voffB); PG8_STAGE(PG8_SB(0, 1), cB + hstep, voffB); PG8_STAGE(PG8_SA(0, 0), cA, voffA); PG8_STAGE(PG8_SA(0, 1), cA + hstep, voffA);
        if (wr == 1) PG8_BAR;
        PG8_WAIT_V(2); PG8_BAR;
        PG8_STAGE(PG8_SB(1, 0), cB + kstep, voffB); PG8_STAGE(PG8_SA(1, 0), cA + kstep, voffA); PG8_STAGE(PG8_SB(1, 1), cB + hstep + kstep, voffB);
        PG8_WAIT_V(6); PG8_BAR;
    } else {
    PG8_STAGE(PG8_SB(0, 0), cB, voffB); PG8_STAGE(PG8_SA(0, 0), cA, voffA); PG8_STAGE(PG8_SB(0, 1), cB + hstep, voffB); PG8_STAGE(PG8_SA(0, 1), cA + hstep, voffA);
    if (wr == 1) PG8_BAR;
    PG8_WAIT_V(4); PG8_BAR;
    PG8_STAGE(PG8_SB(1, 0), cB + kstep, voffB); PG8_STAGE(PG8_SA(1, 0), cA + kstep, voffA); PG8_STAGE(PG8_SB(1, 1), cB + hstep + kstep, voffB);
    PG8_WAIT_V(6); PG8_BAR;
    }
    for (;;) {
        const bool has_next = S.next(ui + 1, nxt);
        const char* nA = has_next ? (const char*)g.A + (size_t)nxt.pm * tstep : cA; const char* nB = has_next ? (const char*)g.Bt + (size_t)nxt.pb * tstep : cB;
        for (int t = 0; t < nt; t += 2) {
            const bool last = (t == nt - 2);
            const char* a1 = cA + (size_t)(t + 1) * kstep;
            const char* a2 = last ? nA : cA + (size_t)(t + 2) * kstep; const char* b2 = last ? nB : cB + (size_t)(t + 2) * kstep;
            const char* a3 = a2 + kstep; const char* b3 = b2 + kstep;
            if constexpr (SP2) {
            PG8_LDB(B0, 0, 0); PG8_LDB(B1, 0, 1); PG8_SCHED; PG8_LDA(At, 0, 0); PG8_STAGE(PG8_SA(1, 1), a1 + hstep, voffA);
            PG8_WAIT_V(8); PG8_WAIT_L(0); PG8_BAR; PG8_MMA(0, 0, At, B0); PG8_MMA(0, 1, At, B1); PG8_BAR; PG8_SCHED;
            PG8_LDA(At, 0, 1); PG8_STAGE(PG8_SB(0, 0), b2, voffB); PG8_STAGE(PG8_SB(0, 1), b2 + hstep, voffB); PG8_STAGE(PG8_SA(0, 0), a2, voffA);
            PG8_WAIT_V(8); PG8_WAIT_L(0); PG8_BAR; PG8_MMA(1, 0, At, B0); PG8_MMA(1, 1, At, B1); PG8_BAR; PG8_SCHED;
            PG8_LDB(B0, 1, 0); PG8_LDB(B1, 1, 1); PG8_SCHED; PG8_LDA(At, 1, 0); PG8_STAGE(PG8_SA(0, 1), a2 + hstep, voffA);
            PG8_WAIT_V(8); PG8_WAIT_L(0); PG8_BAR; PG8_MMA(0, 0, At, B0); PG8_MMA(0, 1, At, B1); PG8_BAR; PG8_SCHED;
            PG8_LDA(At, 1, 1); PG8_STAGE(PG8_SB(1, 0), b3, voffB); PG8_STAGE(PG8_SB(1, 1), b3 + hstep, voffB); PG8_STAGE(PG8_SA(1, 0), a3, voffA);
            PG8_WAIT_V(8); PG8_WAIT_L(0); PG8_BAR; PG8_MMA(1, 0, At, B0); PG8_MMA(1, 1, At, B1); PG8_BAR; PG8_SCHED;
            } else {
            PG8_LDB(B0, 0, 0); PG8_SCHED; PG8_LDA(At, 0, 0); PG8_STAGE(PG8_SA(1, 1), a1 + hstep, voffA);
            PG8_WAIT_L(8); PG8_BAR; PG8_WAIT_L(0); PG8_MMA(0, 0, At, B0); PG8_BAR; PG8_SCHED;
            PG8_LDB(B1, 0, 1); PG8_STAGE(PG8_SB(0, 0), b2, voffB);
            PG8_BAR; PG8_WAIT_L(0); PG8_MMA(0, 1, At, B1); PG8_BAR;
            PG8_LDA(At, 0, 1); PG8_STAGE(PG8_SA(0, 0), a2, voffA);
            PG8_BAR; PG8_WAIT_L(0); PG8_MMA(1, 0, At, B0); PG8_BAR; PG8_SCHED;
            PG8_STAGE(PG8_SB(0, 1), b2 + hstep, voffB);
            PG8_WAIT_V(6); PG8_BAR; PG8_MMA(1, 1, At, B1); PG8_BAR;
            PG8_LDB(B0, 1, 0); PG8_SCHED; PG8_LDA(At, 1, 0); PG8_STAGE(PG8_SA(0, 1), a2 + hstep, voffA);
            PG8_WAIT_L(8); PG8_BAR; PG8_WAIT_L(0); PG8_MMA(0, 0, At, B0); PG8_BAR; PG8_SCHED;
            PG8_LDB(B1, 1, 1); PG8_STAGE(PG8_SB(1, 0), b3, voffB);
            PG8_BAR; PG8_WAIT_L(0); PG8_MMA(0, 1, At, B1); PG8_BAR;
            PG8_LDA(At, 1, 1); PG8_STAGE(PG8_SA(1, 0), a3, voffA);
            PG8_BAR; PG8_WAIT_L(0); PG8_MMA(1, 0, At, B0); PG8_BAR; PG8_SCHED;
            PG8_STAGE(PG8_SB(1, 1), b3 + hstep, voffB);
            PG8_WAIT_V(6); PG8_BAR; PG8_MMA(1, 1, At, B1); PG8_BAR;
            }
        }
        if constexpr (ALIGN_EPI) { if (wr == 0) PG8_BAR; }
        if (F8) asm volatile("s_nop 15\n\ts_nop 15" ::: "memory");
        E(acc, cur, wr, wc, fr, fq);
        if (!has_next) break;
#pragma unroll
        for (int a = 0; a < 2; ++a)
#pragma unroll
            for (int b = 0; b < 2; ++b)
#pragma unroll
                for (int m = 0; m < 4; ++m)
#pragma unroll
                    for (int n = 0; n < 2; ++n) { acc[a][b][m][n] = (f32x4){0.f, 0.f, 0.f, 0.f}; if (F8) asm volatile("" : "+v"(acc[a][b][m][n])); }
        cur = nxt; cA = nA; cB = nB; ++ui;
        if constexpr (ALIGN_EPI) { if (wr == 1) PG8_BAR; }
    }
    PG8_WAIT_V(0);
    if constexpr (!ALIGN_EPI) { if (wr == 0) PG8_BAR; }
    PG8_BAR;
#undef PG8_SA
#undef PG8_SB
#undef PG8_STAGE
#undef PG8_LDA
#undef PG8_LDB
#undef PG8_MMA
#undef PG8_WAIT_V
#undef PG8_WAIT_L
#undef PG8_BAR
#undef PG8_SCHED
}
}

constexpr int NWAVES = 8, NTHR = 512;
constexpr int D = 1024, NB = 16, T = 2048, TC = 256;
constexpr int M_LAT = NB * T, M_CTX = NB * TC, M_ALL = M_LAT + M_CTX;
constexpr int INW = 3328, RW_IN = 1760;
constexpr int C_R = 0, C_GG = 512, C_Q = 1024, C_K = 1280, C_V = 1792, C_WDF = 2304, C_WDB = 2336, C_ADF = 2368, C_ADB = 2400, C_GD = 2432;
constexpr int C_KG = 2528, C_VG = 2784, C_GADF = 3296, C_GADB = 3312;
constexpr int MU_SHIFT = 768;
__host__ __device__ constexpr int zcol_of_src(int n) {
    return n < 512 ? n : n < 1760 ? n + 768 : n < 2016 ? n - 736 : n < 2784 ? n + 512 : n < 3296 ? n - 2272 : n; }
constexpr int NE = 16, FF = 2816, CAP = 256;
constexpr float LN_EPS = 1e-5f, GN_EPS = 64e-5f, GLA_EPS = 1e-5f;
constexpr float DN_ALPHA = 1.189207115002721f;
enum { I_X = 0, I_C, I_CTX, I_CCTX, I_ADAW, I_ADAB, I_WIN, I_MU, I_W0, I_W2, I_A0, I_A2, I_G2, I_KK, I_KA, I_RK, I_GNW, I_GNB, I_GLA2, I_GLAB, I_GLNW, I_WOUT,
       I_LN1G, I_LN1B, I_RTW, I_EXG, I_EXU, I_EXD, I_LN2G, I_LN2B, N_IN };

constexpr size_t MiB = 1u << 20;
constexpr size_t WS_CTL = 0, CTL_ZERO_BYTES = 1 * MiB;
constexpr size_t WS_MOD = 1 * MiB;
constexpr size_t WS_WIN = 2 * MiB;
constexpr size_t WS_WOUT = 9 * MiB;
constexpr size_t WS_G2T = 11 * MiB;
constexpr size_t WS_WGU = 12 * MiB;
constexpr size_t WS_WD = 100 * MiB;
constexpr size_t WS_H0 = 276 * MiB;
constexpr size_t WS_O = 276 * MiB;
constexpr size_t WS_Z = 404 * MiB;
constexpr size_t WS_CB = 638 * MiB;
constexpr size_t WS_MIX = 640 * MiB;
constexpr size_t WS_PROJ = 276 * MiB;
constexpr size_t WS_XIN = 276 * MiB;
constexpr size_t WS_HH = 340 * MiB;
constexpr size_t WS_YE = 516 * MiB;
constexpr size_t WS_X1 = 580 * MiB;
constexpr size_t WS_H2 = 644 * MiB;
constexpr size_t WS_AFF = 676 * MiB;
constexpr size_t WS_SELPOS = 678 * MiB;
constexpr size_t WS_GATE = 680 * MiB;
constexpr size_t WS_END = 704 * MiB;
#ifndef INPROJ_F8
#define INPROJ_F8 0
#endif
constexpr float HA_SCALE = 8.0f, WIN_SCALE = 256.0f;
#ifndef OUTPROJ_F8
#define OUTPROJ_F8 1
#endif
constexpr float MIX_SCALE = 8.0f, WOUT_SCALE = 256.0f;
constexpr float XIN_L = 1.44269504088896f;
constexpr float W1_SCALE = 32.0f, W2_SCALE = 64.0f, H_SCALE = XIN_L * XIN_L, YE_SCALE = 16.0f;
constexpr int CW_TMO = 0;
constexpr int CW_BAR = 4096;

constexpr int RING_BYTES = 131072;
constexpr int LDSCTL_OFF = RING_BYTES, MISC_OFF = LDSCTL_OFF + 320;
constexpr int LDS_BYTES = 147456;

#define LAS __attribute__((address_space(3)))
typedef unsigned short bf16;
typedef unsigned v4u __attribute__((ext_vector_type(4)));
typedef unsigned v2u __attribute__((ext_vector_type(2)));
typedef float f32x4 __attribute__((ext_vector_type(4)));
typedef float f32x2 __attribute__((ext_vector_type(2)));
typedef short bf16x8 __attribute__((ext_vector_type(8)));
#define RLX_AGENT __ATOMIC_RELAXED, __HIP_MEMORY_SCOPE_AGENT
typedef __bf16 hwbf16x2 __attribute__((ext_vector_type(2)));
__device__ __forceinline__ unsigned pk2(float lo, float hi) { const f32x2 v = {lo, hi}; return __builtin_bit_cast(unsigned, __builtin_convertvector(v, hwbf16x2)); }
__device__ __forceinline__ unsigned f2bf(float f) { return pk2(f, f) & 0xffffu; }
__device__ __forceinline__ float bflo(unsigned w) { return __builtin_bit_cast(float, w << 16); }
__device__ __forceinline__ float bfhi(unsigned w) { return __builtin_bit_cast(float, w & 0xffff0000u); }
__device__ __forceinline__ float bf1(bf16 h) { return __builtin_bit_cast(float, ((unsigned)h) << 16); }
__device__ __forceinline__ void unpack4_fp8(unsigned w, float* f) { f[0] = __builtin_amdgcn_cvt_f32_fp8(w, 0); f[1] = __builtin_amdgcn_cvt_f32_fp8(w, 1); f[2] = __builtin_amdgcn_cvt_f32_fp8(w, 2); f[3] = __builtin_amdgcn_cvt_f32_fp8(w, 3); }
__device__ __forceinline__ void unpack8(const v4u w, float* f) { f[0] = bflo(w.x); f[1] = bfhi(w.x); f[2] = bflo(w.y); f[3] = bfhi(w.y); f[4] = bflo(w.z); f[5] = bfhi(w.z); f[6] = bflo(w.w); f[7] = bfhi(w.w); }
template <int CTRL> __device__ __forceinline__ float dppmov(float v) { return __builtin_bit_cast(float, __builtin_amdgcn_update_dpp(0, __builtin_bit_cast(int, v), CTRL, 0xF, 0xF, true)); }
__device__ __forceinline__ float red4(float x) { x += dppmov<0xB1>(x); x += dppmov<0x4E>(x); return x; }
__device__ __forceinline__ float red8(float x) { x = red4(x); x += dppmov<0x141>(x); return x; }
__device__ __forceinline__ float red16(float x) { x = red8(x); x += dppmov<0x140>(x); return x; }
__device__ __forceinline__ float wave_sum(float v) {
#pragma unroll
    for (int o = 1; o < 64; o <<= 1) v += __shfl_xor(v, o);
    return v;
}
__device__ __forceinline__ float wave_sum_dpp(float x) {
    x += dppmov<0xB1>(x); x += dppmov<0x4E>(x); x += dppmov<0x124>(x); x += dppmov<0x128>(x);
    x += __builtin_bit_cast(float, __builtin_amdgcn_update_dpp(0, __builtin_bit_cast(int, x), 0x142, 0xA, 0xF, false));
    x += __builtin_bit_cast(float, __builtin_amdgcn_update_dpp(0, __builtin_bit_cast(int, x), 0x143, 0xC, 0xF, false));
    return __builtin_bit_cast(float, __builtin_amdgcn_readlane(__builtin_bit_cast(int, x), 63));
}
__device__ __forceinline__ float fexp(float x) { return __builtin_amdgcn_exp2f(x * 1.44269504088896f); }
__device__ __forceinline__ float fsigmoid(float x) { return __builtin_amdgcn_rcpf(1.0f + fexp(-x)); }
__device__ __forceinline__ float sigmoidf_(float x) { return 1.0f / (1.0f + expf(-x)); }

#define XB_TMO      128
#define XB_XCNT(j)  (256  + 64 * (j))
#define XB_XSUB(j)  (1280 + 64 * (j))
#define XB_XGEN(j)  (2304 + 64 * (j))
#define XB_TOP      3328
#define XB_TOPGEN   3392
#define XCD_BAR_WORDS 3456
#define XB_SPIN_CAP (1u << 18)
__device__ __forceinline__ unsigned xb_ld(unsigned* p)              { return __hip_atomic_load(p, __ATOMIC_RELAXED, __HIP_MEMORY_SCOPE_AGENT); }
__device__ __forceinline__ unsigned xb_add(unsigned* p, unsigned v) { return __hip_atomic_fetch_add(p, v, __ATOMIC_RELAXED, __HIP_MEMORY_SCOPE_AGENT); }
__device__ __forceinline__ unsigned xb_xcc_id() { return (unsigned)__builtin_amdgcn_s_getreg((3 << 11) | 20) & 0xFu; }
#define XB_SPIN(cond, bar) do { unsigned _sp = 0; while (cond) { __builtin_amdgcn_s_sleep(1); \
    if ((++_sp & 255u) == 0u) { if (xb_ld(&(bar)[XB_TMO])) break; if (_sp > XB_SPIN_CAP) { atomicAdd(&(bar)[XB_TMO], 1u); break; } } } } while (0)
struct XcdBarrier { unsigned* bar; unsigned x; volatile LAS unsigned* st; };
__device__ __forceinline__ XcdBarrier xcd_barrier_post(unsigned* bar, volatile LAS unsigned* st) {
    XcdBarrier b; b.bar = bar; b.x = xb_xcc_id(); b.st = st;
    if (threadIdx.x == 0) (void)xb_add(&bar[XB_XCNT(b.x)], 1u);
    return b;
}
__device__ __forceinline__ void xcd_barrier_complete(unsigned* bar, unsigned x, unsigned& nloc, unsigned& nx) {
    const unsigned G = gridDim.x * gridDim.y * gridDim.z;
    unsigned sum, cnt, mine, sp = 0u;
    for (;;) {
        sum = 0u; cnt = 0u; mine = 0u;
#pragma unroll
        for (unsigned j = 0; j < 16; ++j) { const unsigned c = xb_ld(&bar[XB_XCNT(j)]); sum += c; cnt += (c > 0u) ? 1u : 0u; mine = (j == x) ? c : mine; }
        if (sum == G) break;
        __builtin_amdgcn_s_sleep(1);
        if ((++sp & 255u) == 0u) { if (xb_ld(&bar[XB_TMO])) break; if (sp > XB_SPIN_CAP) { atomicAdd(&bar[XB_TMO], 1u); break; } }
    }
    nloc = mine > 0u ? mine : 1u; nx = cnt > 0u ? cnt : 1u;
}
__device__ __forceinline__ void xcd_barrier(const XcdBarrier& b) {
    asm volatile("s_waitcnt vmcnt(0)" ::: "memory");
    __syncthreads();
    if (threadIdx.x == 0) {
        unsigned* bar = b.bar;
        __builtin_amdgcn_s_waitcnt(0);
        unsigned nloc = b.st[0], nx = b.st[1];
        if (nloc == 0u) { xcd_barrier_complete(bar, b.x, nloc, nx); b.st[0] = nloc; b.st[1] = nx; }
        const unsigned old = xb_add(&bar[XB_XSUB(b.x)], 1u);
        const unsigned gen = old / nloc;
        if (old + 1u == (gen + 1u) * nloc) {
            __builtin_amdgcn_fence(__ATOMIC_RELEASE, "agent");
            asm volatile("s_waitcnt vmcnt(0)" ::: "memory");
            const unsigned og = xb_add(&bar[XB_TOP], 1u);
            const unsigned tg = og / nx;
            if (og + 1u == (tg + 1u) * nx) xb_add(&bar[XB_TOPGEN], 1u);
            else XB_SPIN(xb_ld(&bar[XB_TOPGEN]) == tg, bar);
            __builtin_amdgcn_fence(__ATOMIC_ACQUIRE, "agent");
            xb_add(&bar[XB_XGEN(b.x)], 1u);
            asm volatile("s_waitcnt vmcnt(0)" ::: "memory");
        } else {
            XB_SPIN(xb_ld(&bar[XB_XGEN(b.x)]) == gen, bar);
            __builtin_amdgcn_fence(__ATOMIC_ACQUIRE, "agent");
            asm volatile("s_waitcnt vmcnt(0)" ::: "memory");
        }
    }
    __syncthreads();
}

struct Args { const float* in[N_IN]; float* out; unsigned char* ws; int ph_lo, ph_hi; };
struct Frame {
    LAS unsigned char* lds;
    int tid, lane, wave, G, bid;
    const float* const* in; float* out; unsigned char* ws;
};
#define WSP(T_, off) ((T_*)(F.ws + (off)))

__device__ __forceinline__ int zrow_lat(int b, int t) { return b * T + t; }
__device__ __forceinline__ int zrow_ctx(int b, int t) { return M_LAT + b * TC + t; }

struct Nbr { int r[4]; float m[4]; float coef; };
__device__ __forceinline__ Nbr nbr_of(int row) {
    Nbr n;
    if (row < M_LAT) { const int t = row & (T - 1), gx = t & 63, gy = t >> 6;
        const bool l = gx > 0, r = gx < 63, u = gy > 0, d = gy < 31;
        n.r[0] = l ? row - 1 : row; n.r[1] = r ? row + 1 : row; n.r[2] = u ? row - 64 : row; n.r[3] = d ? row + 64 : row;
        n.m[0] = l ? 1.f : 0.f; n.m[1] = r ? 1.f : 0.f; n.m[2] = u ? 1.f : 0.f; n.m[3] = d ? 1.f : 0.f; n.coef = 0.25f;
    } else { const int t = (row - M_LAT) & (TC - 1); const bool l = t > 0, r = t < TC - 1;
        n.r[0] = l ? row - 1 : row; n.r[1] = r ? row + 1 : row; n.r[2] = row; n.r[3] = row;
        n.m[0] = l ? 1.f : 0.f; n.m[1] = r ? 1.f : 0.f; n.m[2] = 0.f; n.m[3] = 0.f; n.coef = 0.5f; }
    return n;
}
__device__ __forceinline__ void shift8(const v4u c, const v4u* nb, const Nbr& n, const float* mu8, float* out) {
    float zc[8], acc[8], t[8]; unpack8(c, zc);
#pragma unroll
    for (int e = 0; e < 8; ++e) acc[e] = 0.f;
#pragma unroll
    for (int q = 0; q < 4; ++q) { unpack8(nb[q], t);
#pragma unroll
        for (int e = 0; e < 8; ++e) acc[e] += n.m[q] * t[e]; }
#pragma unroll
    for (int e = 0; e < 8; ++e) out[e] = zc[e] + (n.coef * acc[e] - zc[e]) * mu8[e];
}

__device__ __forceinline__ void p0_mod_item(Frame& F, int item) {
    LAS float* S = (LAS float*)F.lds;
    LAS float* RED = S + 17 * 1024;
    const float* c = F.in[I_C]; const float* cc = F.in[I_CCTX]; const float* W = F.in[I_ADAW]; const float* bias = F.in[I_ADAB];
    const int kg = F.tid >> 5, col = F.tid & 31, n0 = item * 32;
    float wall[64];
#pragma unroll
    for (int q = 0; q < 64; ++q) wall[q] = W[(size_t)(kg * 64 + q) * (6 * D) + n0 + col];
    for (int i = F.tid; i < 17 * 1024; i += NTHR) { const float v = (i < 16 * 1024) ? c[i] : cc[i - 16 * 1024]; S[i] = v * fsigmoid(v); }
    __syncthreads();
    float acc[17];
#pragma unroll
    for (int r = 0; r < 17; ++r) acc[r] = 0.f;
#pragma unroll
    for (int k8 = 0; k8 < 8; ++k8) { const int k = kg * 64 + 8 * k8;
#pragma unroll
        for (int r = 0; r < 17; ++r) { const f32x4 s0 = *(const LAS f32x4*)(S + r * 1024 + k), s1 = *(const LAS f32x4*)(S + r * 1024 + k + 4);
            acc[r] += (s0.x * wall[8 * k8] + s0.y * wall[8 * k8 + 1]) + (s0.z * wall[8 * k8 + 2] + s0.w * wall[8 * k8 + 3]) + (s1.x * wall[8 * k8 + 4] + s1.y * wall[8 * k8 + 5]) + (s1.z * wall[8 * k8 + 6] + s1.w * wall[8 * k8 + 7]); }
    }
#pragma unroll
    for (int r = 0; r < 17; ++r) RED[(kg * 17 + r) * 32 + col] = acc[r];
    __syncthreads();
    float* mod = WSP(float, WS_MOD);
    for (int i = F.tid; i < 17 * 32; i += NTHR) { const int r = i >> 5, cl = i & 31; float s = bias[n0 + cl];
#pragma unroll
        for (int g = 0; g < 16; ++g) s += RED[(g * 17 + r) * 32 + cl];
        mod[r * (6 * D) + n0 + cl] = s; }
    __syncthreads();
}
__device__ __forceinline__ void p0_transpose_item(const float* W, int N, int K, bf16* WT, int drow0, int k0, int n0, LAS float* scr, int lane) {
#pragma unroll 8
    for (int i = 0; i < 32; ++i) { const int kk = 2 * i + (lane >> 5); scr[kk * 33 + (lane & 31)] = W[(size_t)(k0 + kk) * N + n0 + (lane & 31)]; }
    asm volatile("s_waitcnt vmcnt(0) lgkmcnt(0)" ::: "memory");
    const int c = lane & 7;
#pragma unroll
    for (int j = 0; j < 4; ++j) { const int n = (lane >> 3) + 8 * j; const LAS float* s = scr + (8 * c) * 33 + n;
        v4u o; o.x = pk2(s[0 * 33], s[1 * 33]); o.y = pk2(s[2 * 33], s[3 * 33]); o.z = pk2(s[4 * 33], s[5 * 33]); o.w = pk2(s[6 * 33], s[7 * 33]);
        *(v4u*)(WT + (size_t)(drow0 + n) * K + k0 + 8 * c) = o; }
    asm volatile("s_waitcnt lgkmcnt(0)" ::: "memory");
}
__device__ __forceinline__ float clamp448f(float x) { return __builtin_amdgcn_fmed3f(x, -448.0f, 448.0f); }
__device__ __forceinline__ unsigned pk4_fp8(float a, float b, float c, float d) { unsigned w = __builtin_amdgcn_cvt_pk_fp8_f32(a, b, 0, false); return __builtin_amdgcn_cvt_pk_fp8_f32(c, d, w, true); }
__device__ __forceinline__ void p0_transpose_item_f8(const float* W, int N, int K, unsigned char* WT, int drow0, int k0, int n0, float scale, LAS float* scr, int lane) {
#pragma unroll 8
    for (int i = 0; i < 32; ++i) { const int kk = 2 * i + (lane >> 5); scr[kk * 33 + (lane & 31)] = W[(size_t)(k0 + kk) * N + n0 + (lane & 31)]; }
    asm volatile("s_waitcnt vmcnt(0) lgkmcnt(0)" ::: "memory");
    const int n = lane & 31, hf = lane >> 5; const LAS float* sp = scr + (32 * hf) * 33 + n;
    unsigned w[8];
#pragma unroll
    for (int q = 0; q < 8; ++q) w[q] = pk4_fp8(sp[(4 * q) * 33] * scale, sp[(4 * q + 1) * 33] * scale, sp[(4 * q + 2) * 33] * scale, sp[(4 * q + 3) * 33] * scale);
    v4u* dst = (v4u*)(WT + (size_t)(drow0 + n) * K + k0 + 32 * hf);
    dst[0] = (v4u){w[0], w[1], w[2], w[3]}; dst[1] = (v4u){w[4], w[5], w[6], w[7]};
    asm volatile("s_waitcnt lgkmcnt(0)" ::: "memory");
}
__device__ __forceinline__ void p0_prologue(Frame& F) {
    __syncthreads();
    for (int it = F.bid; it < 192; it += F.G) p0_mod_item(F, it);
    __syncthreads();
    LAS float* scr = (LAS float*)(F.lds + F.wave * 16384);
    const int gw = F.bid * NWAVES + F.wave, NGW = F.G * NWAVES;
#ifndef SIDEJOB
#define SIDEJOB 1
#endif
    constexpr int I_IN = (D / 64) * (INW / 32), I_OUT = (D / 64) * (D / 32), I_GU = (D / 64) * (FF / 32), I_DN = (FF / 64) * (D / 32);
    constexpr int NITEMS = I_IN + I_OUT + (SIDEJOB ? 0 : NE * (2 * I_GU + I_DN));
    for (int it = gw; it < NITEMS; it += NGW) {
        int r = it;
        if (r < I_IN) { const int nblk = INW / 32, kb = r / nblk, nb = r % nblk;
#if INPROJ_F8
            p0_transpose_item_f8(F.in[I_WIN], INW, D, WSP(unsigned char, WS_WIN), zcol_of_src(32 * nb), 64 * kb, 32 * nb, WIN_SCALE, scr, F.lane);
#else
            p0_transpose_item(F.in[I_WIN], INW, D, WSP(bf16, WS_WIN), zcol_of_src(32 * nb), 64 * kb, 32 * nb, scr, F.lane);
#endif
            continue; } r -= I_IN;
        if (r < I_OUT) { const int nblk = D / 32, kb = r / nblk, nb = r % nblk;
#if OUTPROJ_F8
            p0_transpose_item_f8(F.in[I_WOUT], D, D, WSP(unsigned char, WS_WOUT), 32 * nb, 64 * kb, 32 * nb, WOUT_SCALE, scr, F.lane);
#else
            p0_transpose_item(F.in[I_WOUT], D, D, WSP(bf16, WS_WOUT), 32 * nb, 64 * kb, 32 * nb, scr, F.lane);
#endif
            continue; } r -= I_OUT;
        const int e = r / (2 * I_GU + I_DN); r -= e * (2 * I_GU + I_DN);
        if (r < 2 * I_GU) { const int up = r >= I_GU ? 1 : 0; r -= up * I_GU; const int nblk = FF / 32, kb = r / nblk, nb = r % nblk, n0 = 32 * nb;
            const float* src = (up ? F.in[I_EXU] : F.in[I_EXG]) + (size_t)e * D * FF;
            const int drow = e * (2 * FF) + 256 * (n0 >> 7) + 128 * up + (n0 & 127);
            p0_transpose_item_f8(src, FF, D, WSP(unsigned char, WS_WGU), drow, 64 * kb, n0, W1_SCALE, scr, F.lane); continue; }
        r -= 2 * I_GU;
        { const int nblk = D / 32, kb = r / nblk, nb = r % nblk;
          p0_transpose_item_f8(F.in[I_EXD] + (size_t)e * FF * D, D, FF, WSP(unsigned char, WS_WD), e * D + 32 * nb, 64 * kb, 32 * nb, W2_SCALE, scr, F.lane); }
    }
    { const float* g2 = F.in[I_G2]; bf16* g2t = WSP(bf16, WS_G2T);
      for (int i = F.bid * NTHR + F.tid; i < 512 * 96; i += F.G * NTHR) { const int n = i / 96, k = i % 96; g2t[i] = (bf16)f2bf(g2[k * 512 + n]); } }
}

__device__ __forceinline__ const float* p1_row(Frame& F, int m) { return m < M_LAT ? F.in[I_X] + (size_t)m * D : F.in[I_CTX] + (size_t)(m - M_LAT) * D; }
__device__ __forceinline__ void p1_ln_mod(Frame& F) {
    const int gw = F.bid * NWAVES + F.wave, NGW = F.G * NWAVES;
    const float* mod = WSP(float, WS_MOD); bf16* H0 = WSP(bf16, WS_H0);
    f32x4 nx[4];
    if (gw < M_ALL) { const f32x4* xr = (const f32x4*)p1_row(F, gw) + F.lane;
#pragma unroll
        for (int j = 0; j < 4; ++j) nx[j] = xr[64 * j]; }
    for (int m = gw; m < M_ALL; m += NGW) {
        const int mr = m < M_LAT ? (m >> 11) : 16;
        const f32x4* sh = (const f32x4*)(mod + (size_t)mr * 6 * D) + F.lane; const f32x4* sc = (const f32x4*)(mod + (size_t)mr * 6 * D + D) + F.lane;
        f32x4 shv[4], scv[4];
#pragma unroll
        for (int j = 0; j < 4; ++j) { shv[j] = sh[64 * j]; scv[j] = sc[64 * j]; }
        f32x4 v[4]; float s = 0.f;
#pragma unroll
        for (int j = 0; j < 4; ++j) { v[j] = nx[j]; s += (v[j].x + v[j].y) + (v[j].z + v[j].w); }
        { const f32x4* xr = (const f32x4*)p1_row(F, m + NGW < M_ALL ? m + NGW : m) + F.lane;
#pragma unroll
            for (int j = 0; j < 4; ++j) nx[j] = xr[64 * j]; }
        const float mean = wave_sum_dpp(s) * (1.f / D); float s2 = 0.f;
#pragma unroll
        for (int j = 0; j < 4; ++j) { v[j] = v[j] - mean; s2 += (v[j].x * v[j].x + v[j].y * v[j].y) + (v[j].z * v[j].z + v[j].w * v[j].w); }
        const float rstd = __builtin_amdgcn_rsqf(wave_sum_dpp(s2) * (1.f / D) + LN_EPS);
#if INPROJ_F8
        unsigned* o4 = (unsigned*)((unsigned char*)H0 + (size_t)m * D) + F.lane; const float rs8 = rstd * HA_SCALE;
#pragma unroll
        for (int j = 0; j < 4; ++j) { const f32x4 h = v[j] * rs8 * (scv[j] + 1.0f) + shv[j] * HA_SCALE;
            o4[64 * j] = pk4_fp8(clamp448f(h.x), clamp448f(h.y), clamp448f(h.z), clamp448f(h.w)); }
#else
        unsigned long long* o8 = (unsigned long long*)(H0 + (size_t)m * D) + F.lane;
#pragma unroll
        for (int j = 0; j < 4; ++j) { const f32x4 h = v[j] * rstd * (scv[j] + 1.0f) + shv[j];
            o8[64 * j] = (unsigned long long)pk2(h.x, h.y) | ((unsigned long long)pk2(h.z, h.w) << 32); }
#endif
    }
}

__device__ __forceinline__ int scan_base_row(int n, int dir, int b) { if (n < 16) { const int ci = dir ? 15 - n : n; return zrow_ctx(b, 16 * ci); } const int m = n - 16, li = dir ? 127 - m : m; return zrow_lat(b, 16 * li); }
__device__ __forceinline__ float dot4(const f32x4 a, const f32x4 b) { return (a.x * b.x + a.y * b.y) + (a.z * b.z + a.w * b.w); }
constexpr int SC_ALD = 72, SC_WLD = 40;
__device__ __forceinline__ float pair_red16(const float a0, const float a1, const bool odd) {
    float t = odd ? a1 : a0; const float u = odd ? a0 : a1;
    t += dppmov<0xB1>(u); t += dppmov<0x4E>(t); t += dppmov<0x124>(t); t += dppmov<0x128>(t);
    return t;
}
__device__ __forceinline__ float opq(float x) { asm("" : "+v"(x)); return x; }
struct S8 { float a[8]; };
template <bool LAT>
__device__ __forceinline__ void scan_steps(const LAS float* VEC, LAS float* YB, const int dir, const int kg, const int row0, S8& S) {
    const int sstr = dir ? -64 : 64; const bool odd = (kg & 1) != 0; const int kh2 = kg >> 1;
    const LAS float* p0 = VEC + (dir ? 15 * 64 : 0) + 4 * kg;
    const LAS float* pv = VEC + 5 * 1024 + (dir ? 15 * 64 : 0) + row0;
    f32x4 w4 = *(const LAS f32x4*)p0, ka4 = *(const LAS f32x4*)(p0 + 2048), kh4 = *(const LAS f32x4*)(p0 + 3072), r4 = *(const LAS f32x4*)(p0 + 4096);
    f32x2 v2 = *(const LAS f32x2*)pv;
    f32x4 kkn = *(const LAS f32x4*)(p0 + 1024);
    float skp;
    { float d0 = S.a[0] * kkn[0], d1 = S.a[4] * kkn[0];
#pragma unroll
      for (int e = 1; e < 4; ++e) { d0 = __builtin_fmaf(S.a[e], kkn[e], d0); d1 = __builtin_fmaf(S.a[4 + e], kkn[e], d1); }
      skp = pair_red16(d0, d1, odd); }
    kkn = *(const LAS f32x4*)(p0 + sstr + 1024);
    float keepA = 0.f, keepB = 0.f;
#pragma unroll
    for (int s = 0; s < 16; ++s) {
        const LAS float* pn = p0 + (s + 1) * sstr;
        f32x4 w4n, ka4n, kh4n, r4n, kk2; f32x2 v2n;
        if (s < 15) { w4n = *(const LAS f32x4*)pn; ka4n = *(const LAS f32x4*)(pn + 2048); kh4n = *(const LAS f32x4*)(pn + 3072); if (LAT) r4n = *(const LAS f32x4*)(pn + 4096); v2n = *(const LAS f32x2*)(pv + (s + 1) * sstr); }
        if (s < 14) kk2 = *(const LAS f32x4*)(pn + sstr + 1024);
        const float sk0 = -dppmov<0xA0>(skp), sk1 = -dppmov<0xF5>(skp);
        float d0 = 0.f, d1 = 0.f, y0 = 0.f, y1 = 0.f;
#pragma unroll
        for (int e = 0; e < 4; ++e) {
            float a = opq(S.a[e] * w4[e]); a = __builtin_fmaf(ka4[e], sk0, a); a = opq(__builtin_fmaf(kh4[e], v2.x, a)); S.a[e] = a;
            float c = opq(S.a[4 + e] * w4[e]); c = __builtin_fmaf(ka4[e], sk1, c); c = opq(__builtin_fmaf(kh4[e], v2.y, c)); S.a[4 + e] = c;
            if (s < 15) { d0 = __builtin_fmaf(a, kkn[e], d0); d1 = __builtin_fmaf(c, kkn[e], d1); }
            if (LAT) { y0 = __builtin_fmaf(a, r4[e], y0); y1 = __builtin_fmaf(c, r4[e], y1); }
        }
        if (s < 15) skp = pair_red16(d0, d1, odd);
        if (LAT) { const float ty = pair_red16(y0, y1, odd);
            if ((s & 1) == 0) keepA = (kh2 == (s >> 1)) ? ty : keepA; else keepB = (kh2 == (s >> 1)) ? ty : keepB; }
        if (s < 15) { w4 = w4n; ka4 = ka4n; kh4 = kh4n; if (LAT) r4 = r4n; v2 = v2n; }
        if (s < 14) kkn = kk2;
    }
    if (LAT) { const int st = 2 * kh2; const int iA = dir ? 15 - st : st, iB = dir ? 14 - st : st + 1; const int rr = row0 + (odd ? 1 : 0);
        YB[iA * 64 + rr] = keepA; YB[iB * 64 + rr] = keepB; }
}
constexpr int CV_GU_ITEMS = NE * 2 * (D / 64) * (FF / 32);
constexpr int CV_DN_ITEMS = NE * (FF / 64) * (D / 32);
constexpr int CV_ITEMS = CV_GU_ITEMS + CV_DN_ITEMS;
#ifndef CV_SCALED_CVT
#define CV_SCALED_CVT 1
#endif
struct CvItem { const float* src; unsigned char* dst; int N; int loff; int doff; float scale; int nb, nblk, step, jump; };
__device__ __forceinline__ CvItem cv_item(Frame& F, int it, int lane) {
    const int n = lane & 31, hf = lane >> 5; CvItem c;
    if (it < CV_GU_ITEMS) { const int per_e = 2 * (D / 64) * (FF / 32); const int e = it / per_e; int r = it - e * per_e; const int up = r >= per_e / 2 ? 1 : 0; r -= up * (per_e / 2);
        const int nblk = FF / 32, kb = r / nblk, nb = r % nblk, n0 = 32 * nb, k0 = 64 * kb;
        c.src = (up ? F.in[I_EXU] : F.in[I_EXG]) + (size_t)e * D * FF + (size_t)k0 * FF + n0;
        c.dst = WSP(unsigned char, WS_WGU) + (size_t)(e * (2 * FF) + 256 * (n0 >> 7) + 128 * up + (n0 & 127)) * D + k0; c.N = FF; c.scale = W1_SCALE;
        c.loff = 32 * hf * FF + n; c.doff = n * D + 32 * hf; c.nb = nb; c.nblk = nblk; c.step = 32 * D; c.jump = 128 * D;
    } else { int r = it - CV_GU_ITEMS; const int per_e = (FF / 64) * (D / 32); const int e = r / per_e; r -= e * per_e; const int nblk = D / 32, kb = r / nblk, nb = r % nblk, n0 = 32 * nb, k0 = 64 * kb;
        c.src = F.in[I_EXD] + (size_t)e * FF * D + (size_t)k0 * D + n0;
        c.dst = WSP(unsigned char, WS_WD) + (size_t)(e * D + n0) * FF + k0; c.N = D; c.scale = W2_SCALE;
        c.loff = 32 * hf * D + n; c.doff = n * FF + 32 * hf; c.nb = nb; c.nblk = nblk; c.step = 32 * FF; c.jump = 0; }
    return c;
}
__device__ __forceinline__ void cv_item_next(Frame& F, CvItem& c, int it, int lane) {
    const int nb = c.nb + 1;
    if (nb == c.nblk) { c = cv_item(F, it, lane); return; }
    c.nb = nb; c.src += 32; c.dst += c.step + ((nb & 3) == 0 ? c.jump : 0);
}
struct CvRegs { float v[32]; };
__device__ __forceinline__ void cv_issue(const CvItem& c, CvRegs& R) {
    const char* base = (const char*)c.src; const unsigned offb = (unsigned)c.loff * 4u;
#pragma unroll
    for (int i = 0; i < 32; ++i) { R.v[i] = __builtin_nontemporal_load((const float*)(base + offb)); base += (size_t)c.N * 4; }
}
typedef short cv_s2 __attribute__((ext_vector_type(2)));
__device__ __forceinline__ unsigned pk4_fp8_scaled(float a, float b, float c_, float d, float inv_scale) {
    cv_s2 r = {0, 0}; r = __builtin_amdgcn_cvt_scalef32_pk_fp8_f32(r, a, b, inv_scale, false); r = __builtin_amdgcn_cvt_scalef32_pk_fp8_f32(r, c_, d, inv_scale, true);
    return __builtin_bit_cast(unsigned, r); }
__device__ __forceinline__ void cv_finish(const CvItem& c, const CvRegs& R) {
    v4u* d = (v4u*)(c.dst + c.doff); const float inv = 1.0f / c.scale;
#pragma unroll
    for (int q = 0; q < 2; ++q) { unsigned w[4];
#pragma unroll
        for (int u = 0; u < 4; ++u) { const int i = 16 * q + 4 * u;
#if CV_SCALED_CVT
            w[u] = pk4_fp8_scaled(R.v[i], R.v[i + 1], R.v[i + 2], R.v[i + 3], inv);
#else
            w[u] = pk4_fp8(R.v[i] * c.scale, R.v[i + 1] * c.scale, R.v[i + 2] * c.scale, R.v[i + 3] * c.scale);
#endif
        }
        d[q] = (v4u){w[0], w[1], w[2], w[3]}; }
}
constexpr int VP = 66;
template <int N> __device__ __forceinline__ float dpp_shr(float v) { return __builtin_bit_cast(float, __builtin_amdgcn_update_dpp(0, __builtin_bit_cast(int, v), 0x110 + N, 0xF, 0xF, true)); }
__device__ __forceinline__ float row_prefix16(float x) { x += dpp_shr<1>(x); x += dpp_shr<2>(x); x += dpp_shr<4>(x); x += dpp_shr<8>(x); return x; }
__device__ __forceinline__ float rowpair_sum(float x) {
    const int xi = __builtin_bit_cast(int, x); const auto r = __builtin_amdgcn_permlane16_swap(xi, xi, false, false); const int r0 = r[0], r1 = r[1];
    return __builtin_bit_cast(float, r0) + __builtin_bit_cast(float, r1); }
__device__ __forceinline__ float row_total16(float x) { x += dppmov<0xB1>(x); x += dppmov<0x4E>(x); x += dppmov<0x124>(x); x += dppmov<0x128>(x); return x; }
#ifndef PROBE_SCAN
#define PROBE_SCAN 0
#endif
#ifndef SCAN_B2B_IN_J2
#define SCAN_B2B_IN_J2 0
#endif
#ifndef SJ_W13
#define SJ_W13 1
#endif
#ifndef SJ_ISSUE_IN_J1
#define SJ_ISSUE_IN_J1 0
#endif
#ifndef SOLVER_GROUPED
#define SOLVER_GROUPED 1
#endif
__device__ __forceinline__ void scan_unit(Frame& F, int unit) {
    const int b = unit >> 4, h = (unit >> 1) & 7, dir = unit & 1;
    LAS float* ZS = (LAS float*)F.lds;
    LAS float* TWLA = ZS + 16 * 192;
    LAS float* VV = TWLA + 2 * 16 * 64;
    LAS float* YB = VV + 6 * 16 * VP;
    LAS float* PRM = YB + 16 * 64;
    LAS float* GL2 = PRM + 5 * 64;
    LAS float* MF2 = GL2 + 2 * 64;
    LAS float* RHS = MF2 + 2 * 256;
    LAS bf16* AL = (LAS bf16*)(RHS + 16 * 68);
    LAS bf16* W2T = AL + 16 * SC_ALD;
    LAS bf16* A2T = W2T + 64 * SC_WLD;
    LAS bf16* A12 = A2T + 64 * SC_WLD;
    LAS bf16* B1 = A12 + 2 * 32 * 72;
    LAS bf16* KCT2 = B1 + 32 * 72;
    LAS bf16* EV2 = KCT2 + 2 * 64 * 40;
    LAS bf16* MKI = EV2 + 2 * 64 * 40;
    LAS bf16* AY2 = MKI + 16 * 40;
    LAS bf16* SB = AY2 + 2 * 16 * 40;
    const bf16* Z = WSP(bf16, WS_Z);
    bf16* Y = (bf16*)F.out; float* CB = WSP(float, WS_CB);
    const int tid = F.tid, lane = F.lane, wv = F.wave, fr = lane & 15, fq = lane >> 4;
    __syncthreads();
    for (int i = tid; i < 32 * 64; i += NTHR) { const int j = i >> 6, c = i & 63;
        W2T[c * SC_WLD + j] = (bf16)f2bf(F.in[I_W2][(size_t)(dir * 32 + j) * 512 + h * 64 + c]); A2T[c * SC_WLD + j] = (bf16)f2bf(F.in[I_A2][(size_t)(dir * 32 + j) * 512 + h * 64 + c]); }
    if (tid < 64) { PRM[tid] = F.in[I_W0][dir * 512 + h * 64 + tid]; PRM[64 + tid] = F.in[I_A0][dir * 512 + h * 64 + tid];
        PRM[128 + tid] = F.in[I_KK][h * 64 + tid]; PRM[192 + tid] = F.in[I_KA][h * 64 + tid]; PRM[256 + tid] = F.in[I_RK][h * 64 + tid]; }
    for (int i = tid; i < 64 * 72; i += NTHR) SB[i] = 0;
    for (int i = tid; i < 2 * 64 * 40; i += NTHR) EV2[i] = 0;
    for (int i = tid; i < 16 * 40; i += NTHR) MKI[i] = 0;
    int ia, cg;
    if (wv < 6) { const int id = wv * 64 + lane; ia = id / 24; cg = id - 24 * ia; } else { ia = lane >> 2; cg = (wv == 6 ? 24 : 28) + (lane & 3); }
    int zcol;
    if (cg < 8) zcol = C_R + 64 * h + 8 * cg; else if (cg < 16) zcol = C_K + 64 * h + 8 * (cg - 8); else if (cg < 24) zcol = C_V + 64 * h + 8 * (cg - 16);
    else if (cg < 28) zcol = (dir ? C_WDB : C_WDF) + 8 * (cg - 24); else zcol = (dir ? C_ADB : C_ADF) + 8 * (cg - 28);
    float mu8[8];
#pragma unroll
    for (int e = 0; e < 8; ++e) mu8[e] = F.in[I_MU][zcol - (cg < 8 ? 0 : MU_SHIFT) + e];
    f32x4 Sacc[2] = {{0.f, 0.f, 0.f, 0.f}, {0.f, 0.f, 0.f, 0.f}};
    v4u pc, pn[4];
#define SCAN_GEOM(n_) const int k_ = (n_); const bool lat_ = k_ >= 16; const int li_ = dir ? 127 - (k_ - 16) : k_ - 16, ci_ = dir ? 15 - k_ : k_; \
        const int row0_ = lat_ ? zrow_lat(b, 16 * li_) : zrow_ctx(b, 16 * ci_), spos_ = lat_ ? 16 * (li_ & 3) : 16 * ci_, last_ = lat_ ? 63 : TC - 1; \
        const bool up_ = lat_ && (li_ >> 2) > 0, dn_ = lat_ && (li_ >> 2) < 31; const bool lf_ = spos_ + ia > 0, rt_ = spos_ + ia < last_
#define SCAN_ISSUE(n_) do { SCAN_GEOM(n_); const bf16* pz_ = Z + (size_t)(row0_ + ia) * INW + zcol; pc = *(const v4u*)pz_; \
        pn[0] = *(const v4u*)(pz_ - (lf_ ? INW : 0)); pn[1] = *(const v4u*)(pz_ + (rt_ ? INW : 0)); pn[2] = *(const v4u*)(pz_ - (up_ ? 64 * INW : 0)); pn[3] = *(const v4u*)(pz_ + (dn_ ? 64 * INW : 0)); } while (0)
#define ST_A(n_) do { float zs[8]; { SCAN_GEOM(n_); Nbr nb_; nb_.m[0] = lf_ ? 1.f : 0.f; nb_.m[1] = rt_ ? 1.f : 0.f; nb_.m[2] = up_ ? 1.f : 0.f; nb_.m[3] = dn_ ? 1.f : 0.f; nb_.coef = lat_ ? 0.25f : 0.5f; \
          shift8(pc, pn, nb_, mu8, zs); } \
        if (wv < 6) { *(LAS f32x4*)(ZS + ia * 192 + cg * 8) = (f32x4){zs[0], zs[1], zs[2], zs[3]}; *(LAS f32x4*)(ZS + ia * 192 + cg * 8 + 4) = (f32x4){zs[4], zs[5], zs[6], zs[7]}; } \
        else { if (wv == 6) { _Pragma("unroll") for (int e = 0; e < 8; ++e) zs[e] = 1.0f - 2.0f * __builtin_amdgcn_rcpf(1.0f + __builtin_amdgcn_exp2f(zs[e] * 2.88539008177793f)); } \
            *(LAS v4u*)(AL + ia * SC_ALD + (cg - 24) * 8) = (v4u){pk2(zs[0], zs[1]), pk2(zs[2], zs[3]), pk2(zs[4], zs[5]), pk2(zs[6], zs[7])}; } } while (0)
#define ST_B1_TILE(which_, nt_) do { const int which = (which_), nt = (nt_); \
        const bf16x8 af = *(const LAS bf16x8*)(AL + fr * SC_ALD + 32 * which + 8 * fq); \
        const bf16x8 bfr = *(const LAS bf16x8*)((which ? A2T : W2T) + (16 * nt + fr) * SC_WLD + 8 * fq); \
        const f32x4 acc = __builtin_amdgcn_mfma_f32_16x16x32_bf16(af, bfr, (f32x4){0.f, 0.f, 0.f, 0.f}, 0, 0, 0); \
        _Pragma("unroll") for (int r = 0; r < 4; ++r) TWLA[(which * 16 + 4 * fq + r) * 64 + 16 * nt + fr] = acc[r]; } while (0)
#define ST_B1() do { if (wv != 0) { ST_B1_TILE(wv >> 2, wv & 3); if (wv == 1) ST_B1_TILE(0, 0); } } while (0)
#define ST_B2A(m_) do { const int ib = tid >> 5, c2 = (tid & 31) * 2, sp = dir ? 15 - ib : ib; \
        const f32x2 tw = *(const LAS f32x2*)(TWLA + ib * 64 + c2), la = *(const LAS f32x2*)(TWLA + (16 + ib) * 64 + c2); \
        const f32x2 zr = *(const LAS f32x2*)(ZS + ib * 192 + c2), zk = *(const LAS f32x2*)(ZS + ib * 192 + 64 + c2), zv = *(const LAS f32x2*)(ZS + ib * 192 + 128 + c2); \
        const f32x2 w0 = *(const LAS f32x2*)(PRM + c2), a0 = *(const LAS f32x2*)(PRM + 64 + c2), pkk = *(const LAS f32x2*)(PRM + 128 + c2), pka = *(const LAS f32x2*)(PRM + 192 + c2), prk = *(const LAS f32x2*)(PRM + 256 + c2); \
        float dd[2], aa[2], kh[2], kkr[2]; float ss = 0.f, cbp = 0.f; \
        _Pragma("unroll") for (int q = 0; q < 2; ++q) { \
            dd[q] = 0.60653065971263342f * fsigmoid(w0[q] + tw[q]); aa[q] = fsigmoid(a0[q] + la[q]); \
            kh[q] = zk[q] * (1.0f + (aa[q] - 1.0f) * pka[q]); kkr[q] = zk[q] * pkk[q]; \
            ss += kkr[q] * kkr[q]; cbp += zr[q] * kh[q] * prk[q]; } \
        ss = red16(ss); cbp = red16(cbp); ss = rowpair_sum(ss); cbp = rowpair_sum(cbp); \
        const float rn = __builtin_amdgcn_rsqf(ss + 1e-12f); \
        *(LAS f32x2*)(VV + (0 * 16 + sp) * VP + c2) = (f32x2){dd[0], dd[1]}; \
        *(LAS f32x2*)(VV + (1 * 16 + sp) * VP + c2) = (f32x2){kkr[0] * rn, kkr[1] * rn}; \
        *(LAS f32x2*)(VV + (2 * 16 + sp) * VP + c2) = (f32x2){kkr[0] * rn * aa[0], kkr[1] * rn * aa[1]}; \
        *(LAS f32x2*)(VV + (3 * 16 + sp) * VP + c2) = (f32x2){kh[0], kh[1]}; \
        *(LAS f32x2*)(VV + (4 * 16 + sp) * VP + c2) = zr; \
        *(LAS f32x2*)(VV + (5 * 16 + sp) * VP + c2) = zv; \
        if ((m_) >= 16 && (m_) < 144 && (tid & 31) == 0) CB[((size_t)dir * M_LAT + scan_base_row(m_, dir, b) + ib) * 8 + h] = cbp; } while (0)
#define ST_B2B(par_) do { const int sp = tid & 15, c2 = (tid >> 4) * 2; LAS bf16* A1p = A12 + (par_) * 32 * 72; LAS bf16* KCTp = KCT2 + (par_) * 64 * 40; LAS bf16* EVp = EV2 + (par_) * 64 * 40; \
        const f32x2 dd = *(const LAS f32x2*)(VV + (0 * 16 + sp) * VP + c2), kkn = *(const LAS f32x2*)(VV + (1 * 16 + sp) * VP + c2), kka = *(const LAS f32x2*)(VV + (2 * 16 + sp) * VP + c2), \
                    khv = *(const LAS f32x2*)(VV + (3 * 16 + sp) * VP + c2), rv = *(const LAS f32x2*)(VV + (4 * 16 + sp) * VP + c2), vv = *(const LAS f32x2*)(VV + (5 * 16 + sp) * VP + c2); \
        float okk[2], orr[2], oka[2], okh[2], ohc[2], oac[2]; \
        _Pragma("unroll") for (int q = 0; q < 2; ++q) { const float cum = row_prefix16(dd[q]), tot = row_total16(dd[q]); \
            const float g = fexp(-cum), gi = __builtin_amdgcn_rcpf(g), g15 = fexp(-tot), glg = g15 * gi; \
            const float gm1 = __builtin_bit_cast(float, __builtin_amdgcn_update_dpp(0x3f800000, __builtin_bit_cast(int, g), 0x111, 0xF, 0xF, false)); \
            okk[q] = kkn[q] * gm1; orr[q] = rv[q] * g; oka[q] = kka[q] * gi; okh[q] = khv[q] * gi; ohc[q] = khv[q] * glg; oac[q] = -(kka[q] * glg); \
            if (sp == 15) GL2[(par_) * 64 + c2 + q] = g; } \
        *(LAS unsigned*)(A1p + sp * 72 + c2) = pk2(okk[0], okk[1]); *(LAS unsigned*)(A1p + (16 + sp) * 72 + c2) = pk2(orr[0], orr[1]); \
        *(LAS unsigned*)(B1 + sp * 72 + c2) = pk2(oka[0], oka[1]); *(LAS unsigned*)(B1 + (16 + sp) * 72 + c2) = pk2(okh[0], okh[1]); \
        KCTp[c2 * 40 + sp] = (bf16)f2bf(ohc[0]); KCTp[(c2 + 1) * 40 + sp] = (bf16)f2bf(ohc[1]); \
        KCTp[c2 * 40 + 16 + sp] = (bf16)f2bf(oac[0]); KCTp[(c2 + 1) * 40 + 16 + sp] = (bf16)f2bf(oac[1]); \
        EVp[c2 * 40 + sp] = (bf16)f2bf(vv[0]); EVp[(c2 + 1) * 40 + sp] = (bf16)f2bf(vv[1]); } while (0)
#define ST_G(par_, gw0_) do { if (wv >= (gw0_) && wv < (gw0_) + 4) { const int rs = (wv - (gw0_)) >> 1, cj = (wv - (gw0_)) & 1; f32x4 acc = {0.f, 0.f, 0.f, 0.f}; const LAS bf16* A1p = A12 + (par_) * 32 * 72; \
        _Pragma("unroll") for (int ks = 0; ks < 2; ++ks) acc = __builtin_amdgcn_mfma_f32_16x16x32_bf16(*(const LAS bf16x8*)(A1p + (16 * rs + fr) * 72 + 32 * ks + 8 * fq), *(const LAS bf16x8*)(B1 + (16 * cj + fr) * 72 + 32 * ks + 8 * fq), acc, 0, 0, 0); \
        const int jlim_ = fr - rs;                                     \
        if (rs == 0 && cj == 0) { _Pragma("unroll") for (int r = 0; r < 4; ++r) { const int srow = 4 * fq + r; MF2[(par_) * 256 + srow * 16 + fr] = (fr < srow) ? acc[r] : 0.f; } } \
        else { LAS bf16* gd_ = rs == 0 ? MKI + fr : AY2 + (par_) * 16 * 40 + (cj ? 0 : 16) + fr; const float sg_ = (rs == 1 && cj == 0) ? -1.0f : 1.0f; \
            _Pragma("unroll") for (int r = 0; r < 4; ++r) { const int srow = 4 * fq + r; gd_[srow * 40] = (bf16)f2bf((jlim_ < srow) ? acc[r] * sg_ : 0.f); } } } } while (0)
    CvRegs cvr; CvItem cvi; cvi.src = nullptr; cvi.dst = nullptr; cvi.N = 0; cvi.loff = 0; cvi.doff = 0; cvi.scale = 0.f; cvi.nb = 0; cvi.nblk = 0; cvi.step = 0; cvi.jump = 0;
    bool cv_pending = false;
    SCAN_ISSUE(0);
    ST_A(0); SCAN_ISSUE(1); __syncthreads();
    ST_B1(); __syncthreads();
    ST_B2A(0); __syncthreads();
    ST_B2B(0); ST_A(1); SCAN_ISSUE(2); __syncthreads();
    ST_G(0, 4); ST_B1(); __syncthreads();
    ST_B2A(1); __syncthreads();
    for (int n = 0; n < 144; ++n) {
        const bool is_lat = n >= 16; const int par = n & 1, qar = par ^ 1;
        LAS bf16* A1p = A12 + par * 32 * 72; LAS bf16* EVp = EV2 + par * 64 * 40; LAS bf16* KCTp = KCT2 + par * 64 * 40;
        if (n >= 17) { const int iy = tid >> 5, v2i = (tid & 31) * 2; const f32x2 yv = *(const LAS f32x2*)(YB + iy * 64 + v2i);
            *(unsigned*)(Y + ((size_t)dir * M_LAT + scan_base_row(n - 1, dir, b) + iy) * 512 + h * 64 + v2i) = pk2(yv.x, yv.y); }
#if PROBE_SCAN == 11
        __builtin_amdgcn_s_sleep(16);
#endif
        f32x4 acc1 = {0.f, 0.f, 0.f, 0.f};
        { const int vi = wv & 3, which = wv >> 2;
          if (which == 0 || is_lat) {
#pragma unroll
              for (int ks = 0; ks < 2; ++ks) acc1 = __builtin_amdgcn_mfma_f32_16x16x32_bf16(*(const LAS bf16x8*)(A1p + (16 * which + fr) * 72 + 32 * ks + 8 * fq), *(const LAS bf16x8*)(SB + (16 * vi + fr) * 72 + 32 * ks + 8 * fq), acc1, 0, 0, 0); }
          if (which == 0) { acc1 = __builtin_amdgcn_mfma_f32_16x16x32_bf16(*(const LAS bf16x8*)(MKI + fr * 40 + 8 * fq), *(const LAS bf16x8*)(EVp + (16 * vi + fr) * 40 + 8 * fq), acc1, 0, 0, 0);
#pragma unroll
              for (int r = 0; r < 4; ++r) RHS[(4 * fq + r) * 68 + 16 * vi + fr] = acc1[r]; } }
        ST_A(n + 2 < 144 ? n + 2 : 143);
#if SIDEJOB == 1 && SJ_ISSUE_IN_J1
        if (wv != 0) { const int ph = n - (wv % 3);
            if (ph >= 0) { const int q = ph / 3, pm = ph - 3 * q, li = (wv - 1) + 7 * q;
                if (pm == 0 && li < 264) { cvi = cv_item(F, unit * 264 + li, lane); cv_issue(cvi, cvr); cv_pending = true; } } }
#endif
        SCAN_ISSUE(n + 3 < 144 ? n + 3 : 143);
#if !SCAN_B2B_IN_J2
        ST_B2B(qar);
#endif
        __syncthreads();
#if PROBE_SCAN == 5
        __syncthreads();
#endif
#if PROBE_SCAN == 12
        __builtin_amdgcn_s_sleep(16);
#endif
        ST_B1();
#if SCAN_B2B_IN_J2
        ST_B2B(qar);
#else
        ST_G(qar, 4);
#endif
#if SJ_W13
        if (SIDEJOB == 1 && wv >= 1 && wv <= 3) {
            const int it = unit * 264 + (wv - 1) * 88 + n;
            if (cv_pending) { cv_finish(cvi, cvr); cv_pending = false; }
            if (n < 88) { if (n == 0) cvi = cv_item(F, it, lane); else cv_item_next(F, cvi, it, lane); cv_issue(cvi, cvr); cv_pending = true; } }
#else
        if (SIDEJOB == 1 && wv != 0) {
            const int ph = n - (wv % 3);
            if (ph >= 0) { const int q = ph / 3, pm = ph - 3 * q, li = (wv - 1) + 7 * q;
                if (!SJ_ISSUE_IN_J1 && pm == 0 && li < 264) { cvi = cv_item(F, unit * 264 + li, lane); cv_issue(cvi, cvr); cv_pending = true; }
                if (pm == 1 && cv_pending) { cv_finish(cvi, cvr); cv_pending = false; } } }
#endif
#if PROBE_SCAN == 1
        for (int rep_ = 0; rep_ < 2; ++rep_)
#endif
        if (wv == 0) { float e[16], rh[16]; const LAS float* MFp = MF2 + par * 256;
#if SOLVER_GROUPED
            f32x4 bk0[8], bk1[8];
#define SV_LD(bk_, o_, s_, nb_) do { _Pragma("unroll") for (int q_ = 0; q_ < (nb_); ++q_) bk_[(o_) + q_] = *(const LAS f32x4*)(MFp + (s_) * 16 + 4 * q_); } while (0)
#define SV_ROW(bk_, o_, s_) do { float a_ = rh[s_]; _Pragma("unroll") for (int j_ = 0; j_ < (s_); ++j_) a_ = __builtin_fmaf(-bk_[(o_) + (j_ >> 2)][j_ & 3], e[j_], a_); e[s_] = opq(a_); } while (0)
            SV_LD(bk0, 0, 1, 1); SV_LD(bk0, 1, 2, 1); SV_LD(bk0, 2, 3, 1); SV_LD(bk0, 3, 4, 1); SV_LD(bk0, 4, 5, 2); SV_LD(bk0, 6, 6, 2);
#pragma unroll
            for (int s2 = 0; s2 < 16; ++s2) rh[s2] = RHS[s2 * 68 + lane];
            SV_LD(bk1, 0, 7, 2); SV_LD(bk1, 2, 8, 2); SV_LD(bk1, 4, 9, 3);
            __builtin_amdgcn_sched_barrier(0);
            e[0] = rh[0];
            SV_ROW(bk0, 0, 1); SV_ROW(bk0, 1, 2); SV_ROW(bk0, 2, 3); SV_ROW(bk0, 3, 4); SV_ROW(bk0, 4, 5); SV_ROW(bk0, 6, 6);
            __builtin_amdgcn_sched_barrier(0);
            SV_LD(bk0, 0, 10, 3); SV_LD(bk0, 3, 11, 3);
            __builtin_amdgcn_sched_barrier(0);
            SV_ROW(bk1, 0, 7); SV_ROW(bk1, 2, 8); SV_ROW(bk1, 4, 9);
            __builtin_amdgcn_sched_barrier(0);
            SV_LD(bk1, 0, 12, 3); SV_LD(bk1, 3, 13, 4);
            __builtin_amdgcn_sched_barrier(0);
            SV_ROW(bk0, 0, 10); SV_ROW(bk0, 3, 11);
            __builtin_amdgcn_sched_barrier(0);
            SV_LD(bk0, 0, 14, 4); SV_LD(bk0, 4, 15, 4);
            __builtin_amdgcn_sched_barrier(0);
            SV_ROW(bk1, 0, 12); SV_ROW(bk1, 3, 13);
            __builtin_amdgcn_sched_barrier(0);
            SV_ROW(bk0, 0, 14); SV_ROW(bk0, 4, 15);
#undef SV_LD
#undef SV_ROW
#else
#pragma unroll
            for (int s2 = 0; s2 < 16; ++s2) rh[s2] = RHS[s2 * 68 + lane];
#pragma unroll
            for (int s2 = 0; s2 < 16; ++s2) { float a = rh[s2];
#pragma unroll
                for (int j4 = 0; j4 < (s2 + 3) / 4; ++j4) { const f32x4 m4 = *(const LAS f32x4*)(MFp + s2 * 16 + 4 * j4);
#pragma unroll
                    for (int q = 0; q < 4; ++q) if (4 * j4 + q < s2) a = __builtin_fmaf(-m4[q], e[4 * j4 + q], a); }
                e[s2] = opq(a); asm volatile("" ::: "memory"); }
#endif
            *(LAS v4u*)(EVp + lane * 40 + 16) = (v4u){pk2(e[0], e[1]), pk2(e[2], e[3]), pk2(e[4], e[5]), pk2(e[6], e[7])};
            *(LAS v4u*)(EVp + lane * 40 + 24) = (v4u){pk2(e[8], e[9]), pk2(e[10], e[11]), pk2(e[12], e[13]), pk2(e[14], e[15])}; }
#if PROBE_SCAN == 6
        if (wv == 0) __builtin_amdgcn_s_sleep(8);
#endif
#if PROBE_SCAN == 7
        if (wv != 0) __builtin_amdgcn_s_sleep(8);
#endif
#if PROBE_SCAN == 8
        __builtin_amdgcn_s_sleep(8);
#endif
        __syncthreads();
#if PROBE_SCAN == 5
        __syncthreads();
#endif
        if (wv >= 4 && is_lat) { const int vi = wv & 3;
            acc1 = __builtin_amdgcn_mfma_f32_16x16x32_bf16(*(const LAS bf16x8*)(AY2 + par * 16 * 40 + fr * 40 + 8 * fq), *(const LAS bf16x8*)(EVp + (16 * vi + fr) * 40 + 8 * fq), acc1, 0, 0, 0);
#pragma unroll
            for (int r = 0; r < 4; ++r) { const int sp = 4 * fq + r, it = dir ? 15 - sp : sp; YB[it * 64 + 16 * vi + fr] = acc1[r]; } }
#pragma unroll
        for (int t = 0; t < 2; ++t) { const int tl = 2 * wv + t, vi = tl >> 2, ki = tl & 3;
            f32x4 acc = Sacc[t] * GL2[par * 64 + 16 * ki + fr];
            acc = __builtin_amdgcn_mfma_f32_16x16x32_bf16(*(const LAS bf16x8*)(EVp + (16 * vi + fr) * 40 + 8 * fq), *(const LAS bf16x8*)(KCTp + (16 * ki + fr) * 40 + 8 * fq), acc, 0, 0, 0);
            Sacc[t] = acc;
#pragma unroll
            for (int r = 0; r < 4; ++r) SB[(16 * vi + 4 * fq + r) * 72 + 16 * ki + fr] = (bf16)f2bf(acc[r]); }
#if PROBE_SCAN == 13
        __builtin_amdgcn_s_sleep(16);
#endif
        ST_B2A(n + 2);
#if SCAN_B2B_IN_J2
        ST_G(qar, 0);
#endif
        __syncthreads();
#if PROBE_SCAN == 5
        __syncthreads();
#endif
    }
    { const int iy = tid >> 5, v2i = (tid & 31) * 2; const f32x2 yv = *(const LAS f32x2*)(YB + iy * 64 + v2i);
      *(unsigned*)(Y + ((size_t)dir * M_LAT + scan_base_row(143, dir, b) + iy) * 512 + h * 64 + v2i) = pk2(yv.x, yv.y); }
    if (SIDEJOB == 1 && cv_pending) cv_finish(cvi, cvr);
#undef SCAN_ISSUE
#undef ST_A
#undef ST_B1
#undef ST_B1_TILE
#undef SCAN_GEOM
#undef ST_B2A
#undef ST_B2B
#undef ST_G
    __syncthreads();
}

constexpr int GLD = 72;
__device__ __forceinline__ bf16x8 lds_frag(const LAS bf16* img, int row, int k0) { return *(const LAS bf16x8*)(img + row * GLD + k0); }
__device__ __forceinline__ float flog(float x) { return __builtin_amdgcn_logf(x) * 0.69314718055994531f; }
constexpr int LAFLD = 68;
__device__ __forceinline__ void gla_unit(Frame& F, int unit) {
    const int b = unit >> 4, g = (unit >> 2) & 3, dir = (unit >> 1) & 1, vh = unit & 1;
    LAS bf16* QI = (LAS bf16*)F.lds; LAS bf16* KI = QI + 64 * GLD; LAS bf16* KOT = KI + 64 * GLD; LAS bf16* VT = KOT + 64 * GLD; LAS bf16* SC = VT + 64 * GLD; LAS bf16* ST = SC + 64 * GLD;
    LAS bf16* RQ = ST + 64 * GLD; LAS bf16* RK = RQ + 64 * GLD; LAS bf16* RV = RK + 64 * GLD;
    LAS bf16* OT = RV + 64 * GLD;
    LAS bf16* GADB = OT + 64 * GLD;
    LAS bf16* A2T = GADB + 64 * 40;
    LAS float* LAF = (LAS float*)(A2T + 64 * 40);
    LAS float* BL = LAF + 64 * LAFLD;
    LAS float* PART = BL + 64;
    const bf16* Z = WSP(bf16, WS_Z); bf16* O = WSP(bf16, WS_O);
    const int tid = F.tid, lane = F.lane, wv = F.wave, c = tid & 63, pg = wv;
    const int fr = lane & 15, fq = lane >> 4;
    const int pl = tid >> 3, g8 = tid & 7;
    const float ab = F.in[I_GLAB][dir * 256 + 64 * g + c];
    const int cgad = dir ? C_GADB : C_GADF;
    __syncthreads();
    for (int i = tid; i < 64 * GLD; i += NTHR) ST[i] = 0;
    for (int i = tid; i < 64 * 40; i += NTHR) { GADB[i] = 0; const int cc = i / 40, j = i % 40; A2T[i] = j < 16 ? (bf16)f2bf(F.in[I_GLA2][(size_t)(dir * 16 + j) * 256 + 64 * g + cc]) : (bf16)0; }
    f32x4 Sacc[2] = {{0.f, 0.f, 0.f, 0.f}, {0.f, 0.f, 0.f, 0.f}};
    const int tl0 = 2 * wv;
    v4u rq, rk, rv, rg;
#define GLA_BASE(n_) ((n_) < 4 ? zrow_ctx(b, 64 * (dir ? 3 - (n_) : (n_))) : zrow_lat(b, 64 * (dir ? 31 - ((n_) - 4) : ((n_) - 4))))
#define GLA_ISSUE(n_) do { const bf16* zr_ = Z + (size_t)(GLA_BASE(n_) + (dir ? 63 - pl : pl)) * INW; \
        rq = *(const v4u*)(zr_ + C_Q + 64 * g + 8 * g8); rk = *(const v4u*)(zr_ + C_KG + 64 * g + 8 * g8); rv = *(const v4u*)(zr_ + C_VG + 128 * g + 64 * vh + 8 * g8); \
        rg = *(const v4u*)(zr_ + cgad + 8 * (g8 & 1)); } while (0)
    GLA_ISSUE(0);
    __syncthreads();
    for (int n = 0; n < 36; ++n) {
        const bool is_lat = n >= 4; const int base = GLA_BASE(n);
        *(LAS v4u*)(RQ + pl * GLD + 8 * g8) = rq; *(LAS v4u*)(RK + pl * GLD + 8 * g8) = rk; *(LAS v4u*)(RV + pl * GLD + 8 * g8) = rv;
        if (g8 < 2) *(LAS v4u*)(GADB + pl * 40 + 8 * g8) = rg;
        GLA_ISSUE(n + 1 < 36 ? n + 1 : 35);
        __syncthreads();
#pragma unroll
        for (int t = 0; t < 2; ++t) { const int tl = tl0 + t, pi = tl >> 2, ci = tl & 3;
            const f32x4 acc = __builtin_amdgcn_mfma_f32_16x16x32_bf16(*(const LAS bf16x8*)(GADB + (16 * pi + fr) * 40 + 8 * fq), *(const LAS bf16x8*)(A2T + (16 * ci + fr) * 40 + 8 * fq), (f32x4){0.f, 0.f, 0.f, 0.f}, 0, 0, 0);
#pragma unroll
            for (int r = 0; r < 4; ++r) LAF[(16 * pi + 4 * fq + r) * LAFLD + 16 * ci + fr] = acc[r]; }
        { unsigned vtw[4];
#pragma unroll
          for (int e = 0; e < 4; ++e) vtw[e] = (unsigned)RV[(8 * pg + 2 * e) * GLD + c] | ((unsigned)RV[(8 * pg + 2 * e + 1) * GLD + c] << 16);
          *(LAS v4u*)(VT + c * GLD + 8 * pg) = (v4u){vtw[0], vtw[1], vtw[2], vtw[3]}; }
        __syncthreads();
        float cs[8]; float run = 0.f;
#pragma unroll
        for (int e = 0; e < 8; ++e) { const float sg = LAF[(8 * pg + e) * LAFLD + c] + ab;
            run -= flog(1.0f + fexp(-sg)) * (1.0f / 16.0f); cs[e] = run; }
        PART[pg * 64 + c] = run;
        __syncthreads();
        float pre = 0.f, tot = 0.f;
#pragma unroll
        for (int w = 0; w < 8; ++w) { const float pv = PART[w * 64 + c]; tot += pv; if (w < pg) pre += pv; }
        const float etot = fexp(tot);
        unsigned kow[4];
#pragma unroll
        for (int e = 0; e < 8; e += 2) {
            float ko[2];
#pragma unroll
            for (int u = 0; u < 2; ++u) { const float qv = bf1(RQ[(8 * pg + e + u) * GLD + c]), kv = bf1(RK[(8 * pg + e + u) * GLD + c]);
                const float eb = fexp(pre + cs[e + u]), ieb = __builtin_amdgcn_rcpf(eb); const float qi = qv * 0.125f * eb, ki = kv * ieb; ko[u] = ki * etot;
                QI[(8 * pg + e + u) * GLD + c] = (bf16)f2bf(qi); KI[(8 * pg + e + u) * GLD + c] = (bf16)f2bf(ki); }
            kow[e >> 1] = pk2(ko[0], ko[1]); }
        *(LAS v4u*)(KOT + c * GLD + 8 * pg) = (v4u){kow[0], kow[1], kow[2], kow[3]};
        if (pg == 0) BL[c] = etot;
        __syncthreads();
        if (is_lat) {
#pragma unroll
            for (int t = 0; t < 2; ++t) { const int tl = tl0 + t, mi = tl >> 2, ni = tl & 3; f32x4 acc = {0.f, 0.f, 0.f, 0.f};
                if (ni <= mi) {
#pragma unroll
                    for (int ks = 0; ks < 2; ++ks) acc = __builtin_amdgcn_mfma_f32_16x16x32_bf16(lds_frag(QI, 16 * mi + fr, 32 * ks + 8 * fq), lds_frag(KI, 16 * ni + fr, 32 * ks + 8 * fq), acc, 0, 0, 0); }
#pragma unroll
                for (int r = 0; r < 4; ++r) { const int p = 16 * mi + 4 * fq + r, j = 16 * ni + fr; SC[p * GLD + j] = (bf16)f2bf(j <= p ? acc[r] : 0.f); } }
            __syncthreads();
#pragma unroll
            for (int t = 0; t < 2; ++t) { const int tl = tl0 + t, mi = tl >> 2, vi = tl & 3; f32x4 acc = {0.f, 0.f, 0.f, 0.f};
#pragma unroll
                for (int ks = 0; ks < 2; ++ks) { acc = __builtin_amdgcn_mfma_f32_16x16x32_bf16(lds_frag(SC, 16 * mi + fr, 32 * ks + 8 * fq), lds_frag(VT, 16 * vi + fr, 32 * ks + 8 * fq), acc, 0, 0, 0);
                    acc = __builtin_amdgcn_mfma_f32_16x16x32_bf16(lds_frag(QI, 16 * mi + fr, 32 * ks + 8 * fq), lds_frag(ST, 16 * vi + fr, 32 * ks + 8 * fq), acc, 0, 0, 0); }
#pragma unroll
                for (int r = 0; r < 4; ++r) OT[(16 * mi + 4 * fq + r) * GLD + 16 * vi + fr] = (bf16)f2bf(acc[r]); }
        }
        __syncthreads();
        if (is_lat) *(v4u*)(O + ((size_t)dir * M_LAT + base + (dir ? 63 - pl : pl)) * 512 + 128 * g + 64 * vh + 8 * g8) = *(const LAS v4u*)(OT + pl * GLD + 8 * g8);
#pragma unroll
        for (int t = 0; t < 2; ++t) { const int tl = tl0 + t, ci = tl >> 2, vi = tl & 3;
            f32x4 acc = Sacc[t];
            const f32x4 dk = *(const LAS f32x4*)(BL + 16 * ci + 4 * fq);
            acc = acc * dk;
#pragma unroll
            for (int ks = 0; ks < 2; ++ks) acc = __builtin_amdgcn_mfma_f32_16x16x32_bf16(lds_frag(KOT, 16 * ci + fr, 32 * ks + 8 * fq), lds_frag(VT, 16 * vi + fr, 32 * ks + 8 * fq), acc, 0, 0, 0);
            Sacc[t] = acc;
            *(LAS v2u*)(ST + (16 * vi + fr) * GLD + 16 * ci + 4 * fq) = (v2u){pk2(acc[0], acc[1]), pk2(acc[2], acc[3])}; }
        if (SIDEJOB == 2) { }
    }
#undef GLA_ISSUE
#undef GLA_BASE
    __syncthreads();
}

constexpr int ALD = 104;
constexpr int GOLD = 516;
__device__ __forceinline__ void mix_unit(Frame& F, int unit) {
    LAS float* GO = (LAS float*)F.lds;
    LAS bf16* AI = (LAS bf16*)(GO + 32 * GOLD);
    const bf16* Z = WSP(bf16, WS_Z); const bf16* Y = (const bf16*)F.out; const bf16* O = WSP(bf16, WS_O); const float* CB = WSP(float, WS_CB);
    const bf16* G2T = WSP(bf16, WS_G2T); bf16* MIX = WSP(bf16, WS_MIX);
    const int tid = F.tid, lane = F.lane, wv = F.wave, row00 = unit * 32, fr = lane & 15, fq = lane >> 4;
    __syncthreads();
    if (tid < 32 * 12) { const int i = tid / 12, cgp = tid % 12, row = row00 + i, col = C_GD + 8 * cgp; const Nbr nb = nbr_of(row);
        const v4u pc = *(const v4u*)(Z + (size_t)row * INW + col); v4u pn[4];
#pragma unroll
        for (int q = 0; q < 4; ++q) pn[q] = *(const v4u*)(Z + (size_t)nb.r[q] * INW + col);
        float mu8[8], zs[8];
#pragma unroll
        for (int e = 0; e < 8; ++e) mu8[e] = F.in[I_MU][col - MU_SHIFT + e];
        shift8(pc, pn, nb, mu8, zs);
#pragma unroll
        for (int e = 0; e < 8; ++e) zs[e] = fsigmoid(zs[e]);
        *(LAS v4u*)(AI + i * ALD + 8 * cgp) = (v4u){pk2(zs[0], zs[1]), pk2(zs[2], zs[3]), pk2(zs[4], zs[5]), pk2(zs[6], zs[7])}; }
    __syncthreads();
    {
        bf16x8 af[2][3];
#pragma unroll
        for (int m = 0; m < 2; ++m)
#pragma unroll
            for (int ks = 0; ks < 3; ++ks) af[m][ks] = *(const LAS bf16x8*)(AI + (16 * m + fr) * ALD + 32 * ks + 8 * fq);
#pragma unroll
        for (int nn = 0; nn < 4; ++nn) { const int colb = 64 * wv + 16 * nn;
            bf16x8 bfg[3];
#pragma unroll
            for (int ks = 0; ks < 3; ++ks) bfg[ks] = *(const bf16x8*)(G2T + (size_t)(colb + fr) * 96 + 32 * ks + 8 * fq);
#pragma unroll
            for (int m = 0; m < 2; ++m) { f32x4 acc = {0.f, 0.f, 0.f, 0.f};
#pragma unroll
                for (int ks = 0; ks < 3; ++ks) acc = __builtin_amdgcn_mfma_f32_16x16x32_bf16(af[m][ks], bfg[ks], acc, 0, 0, 0);
#pragma unroll
                for (int r = 0; r < 4; ++r) GO[(16 * m + 4 * fq + r) * GOLD + colb + fr] = acc[r]; } }
    }
    __syncthreads();
    { const int col = 8 * lane, hh = lane >> 3, vcol = C_V + col;
      float mu8[8], gnw[8], gnb[8], glw[8];
#pragma unroll
      for (int e = 0; e < 8; ++e) { mu8[e] = F.in[I_MU][vcol - MU_SHIFT + e]; gnw[e] = F.in[I_GNW][col + e]; gnb[e] = F.in[I_GNB][col + e]; glw[e] = F.in[I_GLNW][col + e]; }
      v4u ny[2], no[2]; v4u npc, npn[4], ngg; float ncb; Nbr nnb;
#define MIX_LOAD(ti_) do { const int row_ = row00 + 4 * wv + (ti_); nnb = nbr_of(row_); \
        ny[0] = *(const v4u*)(Y + (size_t)row_ * 512 + col); ny[1] = *(const v4u*)(Y + ((size_t)M_LAT + row_) * 512 + col); \
        no[0] = *(const v4u*)(O + (size_t)row_ * 512 + col); no[1] = *(const v4u*)(O + ((size_t)M_LAT + row_) * 512 + col); \
        ncb = CB[(size_t)row_ * 8 + hh] + CB[((size_t)M_LAT + row_) * 8 + hh]; \
        npc = *(const v4u*)(Z + (size_t)row_ * INW + vcol); _Pragma("unroll") for (int q_ = 0; q_ < 4; ++q_) npn[q_] = *(const v4u*)(Z + (size_t)nnb.r[q_] * INW + vcol); \
        ngg = *(const v4u*)(Z + (size_t)row_ * INW + C_GG + col); } while (0)
      MIX_LOAD(0);
#pragma unroll
      for (int ti = 0; ti < 4; ++ti) { const int i = 4 * wv + ti, row = row00 + i;
        float yf[8], yb_[8], of[8], ob_[8]; unpack8(ny[0], yf); unpack8(ny[1], yb_); unpack8(no[0], of); unpack8(no[1], ob_);
        const v4u pc = npc, gw4 = ngg; v4u pn[4]; const Nbr nb = nnb; const float cb = ncb;
#pragma unroll
        for (int q = 0; q < 4; ++q) pn[q] = npn[q];
        if (ti < 3) MIX_LOAD(ti + 1);
        { float y[8];
#pragma unroll
          for (int e = 0; e < 8; ++e) y[e] = yf[e] + yb_[e];
          float sm = 0.f;
#pragma unroll
          for (int e = 0; e < 8; ++e) sm += y[e];
          const float mean = red8(sm) * (1.0f / 64.0f); float s2 = 0.f;
#pragma unroll
          for (int e = 0; e < 8; ++e) { y[e] -= mean; s2 += y[e] * y[e]; }
          const float rstd = __builtin_amdgcn_rsqf(red8(s2) * (1.0f / 64.0f) + GN_EPS);
          float vs[8], o[8]; shift8(pc, pn, nb, mu8, vs);
          const f32x4 g0 = *(const LAS f32x4*)(GO + i * GOLD + col), g1 = *(const LAS f32x4*)(GO + i * GOLD + col + 4);
          const float go[8] = {g0.x, g0.y, g0.z, g0.w, g1.x, g1.y, g1.z, g1.w};
#pragma unroll
          for (int e = 0; e < 8; ++e) o[e] = (y[e] * rstd * gnw[e] + gnb[e] + cb * vs[e]) * go[e];
#if OUTPROJ_F8
          { float q_[8];
#pragma unroll
            for (int e = 0; e < 8; ++e) q_[e] = clamp448f(o[e] * MIX_SCALE);
            *(v2u*)((unsigned char*)MIX + (size_t)row * D + col) = (v2u){pk4_fp8(q_[0], q_[1], q_[2], q_[3]), pk4_fp8(q_[4], q_[5], q_[6], q_[7])}; } }
#else
          *(v4u*)(MIX + (size_t)row * D + col) = (v4u){pk2(o[0], o[1]), pk2(o[2], o[3]), pk2(o[4], o[5]), pk2(o[6], o[7])}; }
#endif
        { float o[8];
#pragma unroll
          for (int e = 0; e < 8; ++e) o[e] = of[e] + ob_[e];
          float s2 = 0.f;
#pragma unroll
          for (int e = 0; e < 8; ++e) s2 += o[e] * o[e];
          const float rs = __builtin_amdgcn_rsqf(red16(s2) * (1.0f / 128.0f) + GLA_EPS);
          float gg[8]; unpack8(gw4, gg);
#pragma unroll
          for (int e = 0; e < 8; ++e) o[e] = o[e] * rs * glw[e] * (gg[e] * fsigmoid(gg[e]));
#if OUTPROJ_F8
          { float q_[8];
#pragma unroll
            for (int e = 0; e < 8; ++e) q_[e] = clamp448f(o[e] * MIX_SCALE);
            *(v2u*)((unsigned char*)MIX + (size_t)row * D + 512 + col) = (v2u){pk4_fp8(q_[0], q_[1], q_[2], q_[3]), pk4_fp8(q_[4], q_[5], q_[6], q_[7])}; } }
#else
          *(v4u*)(MIX + (size_t)row * D + 512 + col) = (v4u){pk2(o[0], o[1]), pk2(o[2], o[3]), pk2(o[4], o[5]), pk2(o[6], o[7])}; }
#endif
      }
#undef MIX_LOAD
    }
}

#ifndef P7_TREDUCE
#define P7_TREDUCE 1
#endif
constexpr int RWLD = 1028;
__device__ __forceinline__ void p7_ln_router(Frame& F) {
    const int gw = F.bid * NWAVES + F.wave, NGW = F.G * NWAVES;
    const float* mod = WSP(float, WS_MOD); const bf16* PROJ = WSP(bf16, WS_PROJ); unsigned char* H2 = WSP(unsigned char, WS_H2); float* AFF = WSP(float, WS_AFF);
    LAS float* RWT = (LAS float*)F.lds;
    __syncthreads();
    for (int i = F.tid; i < D * NE; i += NTHR) RWT[(i & 15) * RWLD + (i >> 4)] = F.in[I_RTW][i];
    __syncthreads();
    f32x4 lgv[4], lbv[4];
#pragma unroll
    for (int j = 0; j < 4; ++j) { lgv[j] = ((const f32x4*)F.in[I_LN1G] + F.lane)[64 * j]; lbv[j] = ((const f32x4*)F.in[I_LN1B] + F.lane)[64 * j]; }
    f32x4 nx[4]; v2u np_[4];
    if (gw < M_LAT) { const f32x4* xr = (const f32x4*)(F.in[I_X] + (size_t)gw * D) + F.lane; const v2u* pr = (const v2u*)(PROJ + (size_t)gw * D) + F.lane;
#pragma unroll
        for (int j = 0; j < 4; ++j) { nx[j] = xr[64 * j]; np_[j] = pr[64 * j]; } }
    for (int m = gw; m < M_LAT; m += NGW) {
        const int b = m >> 11; const float* mrow = mod + (size_t)b * 6 * D;
        f32x4 g1v[4], shv[4], scv[4];
#pragma unroll
        for (int j = 0; j < 4; ++j) { g1v[j] = ((const f32x4*)(mrow + 2 * D) + F.lane)[64 * j]; shv[j] = ((const f32x4*)(mrow + 3 * D) + F.lane)[64 * j]; scv[j] = ((const f32x4*)(mrow + 4 * D) + F.lane)[64 * j]; }
        f32x4 v[4]; float s = 0.f;
#pragma unroll
        for (int j = 0; j < 4; ++j) { const f32x4 pj = {bflo(np_[j].x), bfhi(np_[j].x), bflo(np_[j].y), bfhi(np_[j].y)}; v[j] = nx[j] * DN_ALPHA + g1v[j] * pj; s += (v[j].x + v[j].y) + (v[j].z + v[j].w); }
        { const int mn = (m + NGW < M_LAT) ? m + NGW : m;
          const f32x4* xr = (const f32x4*)(F.in[I_X] + (size_t)mn * D) + F.lane; const v2u* pr = (const v2u*)(PROJ + (size_t)mn * D) + F.lane;
#pragma unroll
          for (int j = 0; j < 4; ++j) { nx[j] = xr[64 * j]; np_[j] = pr[64 * j]; } }
        float mean = wave_sum_dpp(s) * (1.f / D); float s2 = 0.f;
#pragma unroll
        for (int j = 0; j < 4; ++j) { v[j] = v[j] - mean; s2 += (v[j].x * v[j].x + v[j].y * v[j].y) + (v[j].z * v[j].z + v[j].w * v[j].w); }
        float rstd = __builtin_amdgcn_rsqf(wave_sum_dpp(s2) * (1.f / D) + LN_EPS);
        unsigned long long* x1 = (unsigned long long*)(WSP(bf16, WS_X1) + (size_t)m * D) + F.lane;
        s = 0.f;
#pragma unroll
        for (int j = 0; j < 4; ++j) { v[j] = v[j] * rstd * lgv[j] + lbv[j]; x1[64 * j] = (unsigned long long)pk2(v[j].x, v[j].y) | ((unsigned long long)pk2(v[j].z, v[j].w) << 32); s += (v[j].x + v[j].y) + (v[j].z + v[j].w); }
        mean = wave_sum_dpp(s) * (1.f / D); s2 = 0.f;
#pragma unroll
        for (int j = 0; j < 4; ++j) { v[j] = v[j] - mean; s2 += (v[j].x * v[j].x + v[j].y * v[j].y) + (v[j].z * v[j].z + v[j].w * v[j].w); }
        rstd = __builtin_amdgcn_rsqf(wave_sum_dpp(s2) * (1.f / D) + LN_EPS);
        unsigned* o4 = (unsigned*)(H2 + (size_t)m * D) + F.lane;
        float lg16[16];
#pragma unroll
        for (int j = 0; j < 4; ++j) { v[j] = v[j] * rstd * (scv[j] + 1.0f) + shv[j];
            o4[64 * j] = pk4_fp8(v[j].x * XIN_L, v[j].y * XIN_L, v[j].z * XIN_L, v[j].w * XIN_L); }
#pragma unroll
        for (int e = 0; e < 16; ++e) { float a = 0.f;
#pragma unroll
            for (int j = 0; j < 4; ++j) { const f32x4 w = *(const LAS f32x4*)(RWT + e * RWLD + 256 * j + 4 * F.lane);
                a = __builtin_fmaf(v[j].x, w.x, a); a = __builtin_fmaf(v[j].y, w.y, a); a = __builtin_fmaf(v[j].z, w.z, a); a = __builtin_fmaf(v[j].w, w.w, a); }
            lg16[e] = a;
            if ((e & 3) == 3) __builtin_amdgcn_sched_barrier(0); }
#if P7_TREDUCE
        float x8[8], y4[4], z2[2];
#pragma unroll
        for (int i = 0; i < 8; ++i) { const auto r = __builtin_amdgcn_permlane32_swap(__builtin_bit_cast(int, lg16[i]), __builtin_bit_cast(int, lg16[i + 8]), false, false);
            const int r0 = r[0], r1 = r[1]; x8[i] = __builtin_bit_cast(float, r0) + __builtin_bit_cast(float, r1); }
#pragma unroll
        for (int i = 0; i < 4; ++i) { const auto r = __builtin_amdgcn_permlane16_swap(__builtin_bit_cast(int, x8[i]), __builtin_bit_cast(int, x8[i + 4]), false, false);
            const int r0 = r[0], r1 = r[1]; y4[i] = __builtin_bit_cast(float, r0) + __builtin_bit_cast(float, r1); }
        const bool b3 = (F.lane & 8) != 0, b2 = (F.lane & 4) != 0;
#pragma unroll
        for (int i = 0; i < 2; ++i) { const float t = b3 ? y4[i + 2] : y4[i], u = b3 ? y4[i] : y4[i + 2]; z2[i] = t + dppmov<0x128>(u); }
        float mine; { const float t = b2 ? z2[1] : z2[0], u = b2 ? z2[0] : z2[1]; mine = t + dppmov<0x141>(u); }
        mine += dppmov<0xB1>(mine); mine += dppmov<0x4E>(mine);
        float mx = fmaxf(mine, dppmov<0x141>(mine)); mx = fmaxf(mx, dppmov<0x140>(mx));
        { const auto r = __builtin_amdgcn_permlane16_swap(__builtin_bit_cast(int, mx), __builtin_bit_cast(int, mx), false, false); const int r0 = r[0], r1 = r[1]; mx = fmaxf(__builtin_bit_cast(float, r0), __builtin_bit_cast(float, r1)); }
        { const auto r = __builtin_amdgcn_permlane32_swap(__builtin_bit_cast(int, mx), __builtin_bit_cast(int, mx), false, false); const int r0 = r[0], r1 = r[1]; mx = fmaxf(__builtin_bit_cast(float, r0), __builtin_bit_cast(float, r1)); }
        const float ex = fexp(mine - mx), den = wave_sum_dpp(ex) * 0.25f;
        if ((F.lane & 3) == 0) AFF[(size_t)m * NE + (F.lane >> 2)] = ex * __builtin_amdgcn_rcpf(den);
#else
        float mx = -1e30f;
#pragma unroll
        for (int e = 0; e < 16; ++e) { lg16[e] = wave_sum_dpp(lg16[e]); mx = fmaxf(mx, lg16[e]); }
        float mine = 0.f;
#pragma unroll
        for (int e = 0; e < 16; ++e) mine = (F.lane == e) ? lg16[e] : mine;
        const float ex = fexp(mine - mx), den = row_total16(ex);
        if (F.lane < 16) AFF[(size_t)m * NE + F.lane] = ex * __builtin_amdgcn_rcpf(den);
#endif
    }
    __syncthreads();
}

__device__ __forceinline__ void p8_topk_unit(Frame& F, int unit) {
    const int b = unit >> 4, e = unit & 15;
    LAS unsigned long long* KEY = (LAS unsigned long long*)F.lds;
    const float* AFF = WSP(float, WS_AFF); int* SELPOS = WSP(int, WS_SELPOS); float* GATE = WSP(float, WS_GATE);
    const unsigned char* H2 = WSP(unsigned char, WS_H2); unsigned char* XIN = WSP(unsigned char, WS_XIN);
    const int tid = F.tid;
    __syncthreads();
    for (int t = tid; t < T; t += NTHR) { const float a = AFF[((size_t)b * T + t) * NE + e];
        KEY[t] = ((unsigned long long)__builtin_bit_cast(unsigned, a) << 32) | (unsigned long long)(0xFFFFFFFFu - (unsigned)t); }
    __syncthreads();
    for (int k = 2; k <= T; k <<= 1)
        for (int j = k >> 1; j > 0; j >>= 1) {
#pragma unroll
            for (int q = 0; q < 2; ++q) { const int pi = tid + NTHR * q; const int i = ((pi & ~(j - 1)) << 1) | (pi & (j - 1)), l = i | j;
                const unsigned long long x = KEY[i], y = KEY[l]; const bool desc = (i & k) == 0;
                if (desc ? (x < y) : (x > y)) { KEY[i] = y; KEY[l] = x; } }
            __syncthreads();
        }
    for (int p = tid; p < T; p += NTHR) { const unsigned long long kv = KEY[p]; const int t = (int)(0xFFFFFFFFu - (unsigned)(kv & 0xFFFFFFFFull));
        SELPOS[((size_t)b * NE + e) * T + t] = p < CAP ? p : -1;
        if (p < CAP) GATE[((size_t)b * NE + e) * CAP + p] = __builtin_bit_cast(float, (unsigned)(kv >> 32)); }
    for (int p0 = F.wave * 8; p0 < CAP; p0 += NWAVES * 8) { v4u rowv[8];
#pragma unroll
        for (int u = 0; u < 8; ++u) { const unsigned long long kv = KEY[p0 + u]; const int t = (int)(0xFFFFFFFFu - (unsigned)(kv & 0xFFFFFFFFull));
            rowv[u] = *((const v4u*)(H2 + ((size_t)b * T + t) * D) + F.lane); }
#pragma unroll
        for (int u = 0; u < 8; ++u) *((v4u*)(XIN + ((size_t)e * (NB * CAP) + b * CAP + p0 + u) * D) + F.lane) = rowv[u]; }
    __syncthreads();
}

struct P11Slots { float g[4]; unsigned y[4][4]; };
__device__ __forceinline__ unsigned long long p11_mask(int pv) { return __builtin_amdgcn_ballot_w64(pv >= 0) & 0xffffull; }
__device__ __forceinline__ void p11_issue(Frame& F, int m, int pv, unsigned long long mask, P11Slots& S) {
    const float* GATE = WSP(float, WS_GATE); const unsigned char* YE = WSP(unsigned char, WS_YE); const int b = m >> 11;
#pragma unroll
    for (int i = 0; i < 4; ++i) { const bool on = mask != 0ull; const int e = on ? (int)__builtin_ctzll(mask) : 0; mask &= mask - 1ull;
        const int pos = on ? __builtin_amdgcn_readlane(pv, e) : 0;
        const float gt = GATE[((size_t)b * NE + e) * CAP + pos]; S.g[i] = on ? gt * (1.0f / YE_SCALE) : 0.f;
        const unsigned* yr = (const unsigned*)(YE + ((size_t)e * (NB * CAP) + b * CAP + pos) * D) + F.lane;
#pragma unroll
        for (int j = 0; j < 4; ++j) S.y[i][j] = yr[64 * j]; }
}
__device__ __forceinline__ void p11_final(Frame& F) {
    const int gw = F.bid * NWAVES + F.wave, NGW = F.G * NWAVES;
    const float* mod = WSP(float, WS_MOD); const int* SELPOS = WSP(int, WS_SELPOS); const float* GATE = WSP(float, WS_GATE); const unsigned char* YE = WSP(unsigned char, WS_YE); const bf16* X1 = WSP(bf16, WS_X1);
    const f32x4* lg = (const f32x4*)F.in[I_LN2G] + F.lane; const f32x4* lb = (const f32x4*)F.in[I_LN2B] + F.lane;
    const int le = F.lane & 15;
    auto p11_pos = [&](int m_) -> int { const int mm = m_ < M_LAT ? m_ : M_LAT - 1;
        const int val = SELPOS[((size_t)(mm >> 11) * NE + le) * T + (mm & (T - 1))]; return (F.lane < 16 && m_ < M_LAT) ? val : -1; };
#define P11_POS(m_) p11_pos(m_)
    f32x4 lgv[4], lbv[4];
#pragma unroll
    for (int j = 0; j < 4; ++j) { lgv[j] = lg[64 * j]; lbv[j] = lb[64 * j]; }
    v2u nx[4]; P11Slots ns; int pv_cur = -1, pv_next = -1;
    if (gw < M_LAT) { const v2u* xr = (const v2u*)(X1 + (size_t)gw * D) + F.lane;
#pragma unroll
        for (int j = 0; j < 4; ++j) nx[j] = xr[64 * j];
        pv_cur = P11_POS(gw); pv_next = P11_POS(gw + NGW);
        p11_issue(F, gw, pv_cur, p11_mask(pv_cur), ns); }
    for (int m = gw; m < M_LAT; m += NGW) {
        const int b = m >> 11; const float* mrow = mod + (size_t)b * 6 * D;
        f32x4 xv[4]; P11Slots cs; const int pv = pv_cur; unsigned long long mask = p11_mask(pv);
#pragma unroll
        for (int j = 0; j < 4; ++j) xv[j] = (f32x4){bflo(nx[j].x), bfhi(nx[j].x), bflo(nx[j].y), bfhi(nx[j].y)};
#pragma unroll
        for (int i = 0; i < 4; ++i) { cs.g[i] = ns.g[i];
#pragma unroll
            for (int j = 0; j < 4; ++j) cs.y[i][j] = ns.y[i][j]; }
        f32x4 g2v[4];
#pragma unroll
        for (int j = 0; j < 4; ++j) g2v[j] = ((const f32x4*)(mrow + 5 * D) + F.lane)[64 * j];
        { const bool more = m + NGW < M_LAT; const int m2 = more ? m + NGW : m; const v2u* xr = (const v2u*)(X1 + (size_t)m2 * D) + F.lane;
#pragma unroll
            for (int j = 0; j < 4; ++j) nx[j] = xr[64 * j];
            pv_cur = pv_next; p11_issue(F, m2, pv_cur, p11_mask(pv_cur), ns); pv_next = P11_POS(more ? m2 + NGW : M_LAT); }
        f32x4 acc[4];
#pragma unroll
        for (int j = 0; j < 4; ++j) acc[j] = (f32x4){0.f, 0.f, 0.f, 0.f};
#pragma unroll
        for (int i = 0; i < 4; ++i) {
#pragma unroll
            for (int j = 0; j < 4; ++j) { float f[4]; unpack4_fp8(cs.y[i][j], f); acc[j].x += cs.g[i] * f[0]; acc[j].y += cs.g[i] * f[1]; acc[j].z += cs.g[i] * f[2]; acc[j].w += cs.g[i] * f[3]; } }
        { unsigned long long rest = mask;
#pragma unroll
          for (int i = 0; i < 4; ++i) rest &= rest - 1ull;
          while (rest != 0ull) { const int e = (int)__builtin_ctzll(rest); rest &= rest - 1ull; const int pos = __builtin_amdgcn_readlane(pv, e);
              const float gt = GATE[((size_t)b * NE + e) * CAP + pos] * (1.0f / YE_SCALE);
              const unsigned* yr = (const unsigned*)(YE + ((size_t)e * (NB * CAP) + b * CAP + pos) * D) + F.lane;
#pragma unroll
              for (int j = 0; j < 4; ++j) { float f[4]; unpack4_fp8(yr[64 * j], f); acc[j].x += gt * f[0]; acc[j].y += gt * f[1]; acc[j].z += gt * f[2]; acc[j].w += gt * f[3]; } } }
        f32x4* x1 = (f32x4*)(F.out + (size_t)m * D) + F.lane;
        f32x4 v[4]; float s = 0.f;
#pragma unroll
        for (int j = 0; j < 4; ++j) { v[j] = xv[j] * DN_ALPHA + g2v[j] * acc[j]; s += (v[j].x + v[j].y) + (v[j].z + v[j].w); }
        const float mean = wave_sum_dpp(s) * (1.f / D); float s2 = 0.f;
#pragma unroll
        for (int j = 0; j < 4; ++j) { v[j] = v[j] - mean; s2 += (v[j].x * v[j].x + v[j].y * v[j].y) + (v[j].z * v[j].z + v[j].w * v[j].w); }
        const float rstd = __builtin_amdgcn_rsqf(wave_sum_dpp(s2) * (1.f / D) + LN_EPS);
#pragma unroll
        for (int j = 0; j < 4; ++j) x1[64 * j] = v[j] * rstd * lgv[j] + lbv[j];
    }
#undef P11_POS
}

constexpr int N_PHASES = 12;
__global__ void __launch_bounds__(NTHR, 2) fwd_kernel(Args args) {
    extern __shared__ __attribute__((aligned(16))) unsigned char lds[];
    Frame F;
    F.lds = (LAS unsigned char*)lds;
    F.tid = threadIdx.x; F.lane = F.tid & 63; F.wave = __builtin_amdgcn_readfirstlane(F.tid >> 6);
    F.G = gridDim.x; F.bid = blockIdx.x;
    F.in = args.in; F.out = args.out; F.ws = args.ws;
    volatile LAS unsigned* MISC = (volatile LAS unsigned*)(F.lds + MISC_OFF);
    for (int u = F.tid; u < (LDS_BYTES - LDSCTL_OFF) / 4; u += NTHR) ((LAS unsigned*)(F.lds + LDSCTL_OFF))[u] = 0u;
    __syncthreads();
    const int lo = args.ph_lo, hi = args.ph_hi;
    const bool multi = (hi - lo) > 1;
    XcdBarrier bar; bar.bar = (unsigned*)(F.ws + WS_CTL) + CW_BAR; bar.x = 0; bar.st = nullptr;
    if (multi) bar = xcd_barrier_post((unsigned*)(F.ws + WS_CTL) + CW_BAR, MISC + 8);
#ifndef PROBE_REP
#define PROBE_REP 0
#endif
#define IN(k) (lo <= (k) && (k) < hi)
#ifndef PROBE_REPN
#define PROBE_REPN 1
#endif
#define REP(k) for (int _r = 0; _r <= PROBE_REPN * ((PROBE_REP >> (k)) & 1); ++_r)
#define SEAM(k) do { if (IN(k) && IN((k) + 1)) xcd_barrier(bar); } while (0)
    using namespace pg8;
    if (IN(0)) REP(0) { p0_prologue(F); } SEAM(0);
    if (IN(1)) REP(1) { p1_ln_mod(F); } SEAM(1);
#ifdef PROBE_BARRIERS
    for (int pb_ = 0; pb_ < PROBE_BARRIERS; ++pb_) xcd_barrier(bar);
#endif
    if (IN(2)) REP(2) {
        Gemm g{WSP(bf16_t, WS_H0), WSP(bf16_t, WS_WIN), M_ALL, INW, D}; InProjOrder S; S.init(M_LAT, M_CTX, INW, 5, F.G, F.bid);
#if INPROJ_F8
        EpiBf16 E{WSP(bf16_t, WS_Z), INW, 1.0f / (HA_SCALE * WIN_SCALE)};
        gemm_phase<EpiBf16, InProjOrder, true>(F.lds, g, S, E);
#else
        EpiBf16 E{WSP(bf16_t, WS_Z), INW, 1.0f};
        gemm_phase<EpiBf16, InProjOrder>(F.lds, g, S, E);
#endif
    } SEAM(2);
    if (IN(3)) REP(3) { for (int u = F.bid; u < 256; u += F.G) scan_unit(F, u); }
    if (IN(4)) REP(4) { for (int u = F.bid; u < 256; u += F.G) gla_unit(F, u); } SEAM(4);
    if (IN(5)) REP(5) { for (int u = F.bid; u < M_LAT / 32; u += F.G) mix_unit(F, u); __syncthreads(); } SEAM(5);
    if (IN(6)) REP(6) {
        Gemm g{WSP(bf16_t, WS_MIX), WSP(bf16_t, WS_WOUT), M_LAT, D, D}; StaticOrder S; S.init(M_LAT, D, F.G, F.bid);
#if OUTPROJ_F8
        EpiBf16 E{WSP(bf16_t, WS_PROJ), D, 1.0f / (MIX_SCALE * WOUT_SCALE)};
        gemm_phase<EpiBf16, StaticOrder, true>(F.lds, g, S, E);
#else
        EpiBf16 E{WSP(bf16_t, WS_PROJ), D, 1.0f};
        gemm_phase<EpiBf16, StaticOrder>(F.lds, g, S, E);
#endif
    } SEAM(6);
    if (IN(7)) REP(7) { p7_ln_router(F); } SEAM(7);
    if (IN(8)) REP(8) { for (int u = F.bid; u < NB * NE; u += F.G) p8_topk_unit(F, u); } SEAM(8);
    if (IN(9)) REP(9) {
        Gemm g{WSP(bf16_t, WS_XIN), WSP(bf16_t, WS_WGU), NE * NB * CAP, 2 * FF, D}; StaticOrder S; S.init(NE * NB * CAP, 2 * FF, F.G, F.bid, 16, 0);
        EpiSwiGLU8 E{WSP(unsigned char, WS_HH), FF, 1.0f / W1_SCALE, H_SCALE};
        gemm_phase<EpiSwiGLU8, StaticOrder, true>(F.lds, g, S, E);
    } SEAM(9);
    if (IN(10)) REP(10) {
        Gemm g{WSP(bf16_t, WS_HH), WSP(bf16_t, WS_WD), NE * NB * CAP, D, FF}; StaticOrder S; S.init(NE * NB * CAP, D, F.G, F.bid, 16, 0);
        EpiF8 E{WSP(unsigned char, WS_YE), D, YE_SCALE / (H_SCALE * W2_SCALE)};
        gemm_phase<EpiF8, StaticOrder, true>(F.lds, g, S, E);
    } SEAM(10);
    if (IN(11)) REP(11) { p11_final(F); }
#undef IN
#undef SEAM
}

extern "C" void kernel_launch(void* const* d_in, const int* in_sizes, int n_in, void* d_out, int out_size, void* d_ws, size_t ws_size, hipStream_t stream) {
    static int grid = 0;
    if (grid == 0) {
        if (n_in != N_IN || out_size != M_LAT * D || ws_size < WS_END) { fprintf(stderr, "kernel_launch: unexpected shapes (n_in %d, out %d, ws %zu)\n", n_in, out_size, ws_size); grid = -1; return; }
        int dev = 0, cus = 0;
        if (hipGetDevice(&dev) != hipSuccess || hipDeviceGetAttribute(&cus, hipDeviceAttributeMultiprocessorCount, dev) != hipSuccess) { grid = -1; return; }
        if (hipFuncSetAttribute((const void*)fwd_kernel, hipFuncAttributeMaxDynamicSharedMemorySize, LDS_BYTES) != hipSuccess) { fprintf(stderr, "kernel_launch: hipFuncSetAttribute failed\n"); grid = -1; return; }
        (void)hipGetLastError();
        grid = cus;
    }
    if (grid < 0) return;
    (void)hipMemsetAsync((char*)d_ws + WS_CTL, 0, CTL_ZERO_BYTES, stream);
    Args a{};
    for (int i = 0; i < N_IN; ++i) a.in[i] = (const float*)d_in[i];
    a.out = (float*)d_out; a.ws = (unsigned char*)d_ws;
#ifndef MK_ONE_LAUNCH
#define MK_ONE_LAUNCH 1
#endif
    if (MK_ONE_LAUNCH) { a.ph_lo = 0; a.ph_hi = N_PHASES; hipLaunchKernelGGL(fwd_kernel, dim3(grid), dim3(NTHR), LDS_BYTES, stream, a); }
    else {
        const int cuts[] = {0, 1, 2, 3, 5, 6, 7, 8, 9, 10, 11, 12};
        for (int li = 0; li + 1 < (int)(sizeof(cuts) / sizeof(cuts[0])); ++li) { a.ph_lo = cuts[li]; a.ph_hi = cuts[li + 1]; hipLaunchKernelGGL(fwd_kernel, dim3(grid), dim3(NTHR), LDS_BYTES, stream, a); }
    }
}
```

```cpp
#include <hip/hip_runtime.h>
#include <cstdio>
#include <cstdint>

namespace pg8 {
#define PG8_LAS __attribute__((address_space(3)))
typedef unsigned short bf16_t;
typedef short bf16x8 __attribute__((ext_vector_type(8)));
typedef float f32x4 __attribute__((ext_vector_type(4)));
typedef unsigned u32x4 __attribute__((ext_vector_type(4)));
typedef unsigned u32x2 __attribute__((ext_vector_type(2)));
typedef int i32x4 __attribute__((ext_vector_type(4)));
typedef int i32x8 __attribute__((ext_vector_type(8)));
constexpr int BM = 256, BK = 64, HALF = 128, HTB = HALF * BK * 2  , STAGE_BYTES = 8 * HTB, NXCD = 8, WGM = 8;

__host__ __device__ __forceinline__ int lds_byte(int r, int c) { const int st = (r >> 4) * 2 + (c >> 5), rr = r & 15, cc = c & 31, ob = rr * 64 + cc * 2; return st * 1024 + (ob ^ (((ob >> 9) & 1) << 5)); }
__host__ __device__ __forceinline__ void stage_rc(int b, int& R, int& C) { const int st = b / 1024, sb = b % 1024, swz = sb ^ (((sb >> 9) & 1) << 5); R = (st >> 1) * 16 + swz / 64; C = (st & 1) * 32 + (swz % 64) / 2; }
__host__ __device__ __forceinline__ int perm32(int rho) { const int n = rho >> 4, i = rho & 15; return 8 * (i >> 2) + 4 * n + (i & 3); }

struct Unit { int pm, pn, pb; };
struct Gemm { const bf16_t* A; const bf16_t* Bt; int M, N, K; };

struct StaticOrder {
    int nM, nN, nwg, G, c, grp, bbase;
    __host__ __device__ void init(int M, int N, int G_, int c_, int grp_ = 0, int bbase_ = 0) { nM = M / BM; nN = N / BM; nwg = nM * nN; G = G_; c = c_; grp = grp_; bbase = bbase_; }
    __host__ __device__ bool next(int i, Unit& u) const {
        const long L = (long)i * G + c; if (L >= nwg) return false;
        int wgid = (int)L; { const int q = nwg / NXCD, r = nwg % NXCD, xcd = wgid % NXCD, off = wgid / NXCD; wgid = (xcd < r ? xcd * (q + 1) : r * (q + 1) + (xcd - r) * q) + off; }
        const int nig = WGM * nN, gid = wgid / nig, fm = gid * WGM, gsz = (nM - fm) < WGM ? (nM - fm) : WGM;
        u.pm = fm + ((wgid % nig) % gsz); u.pn = (wgid % nig) / gsz; u.pb = bbase + (grp ? (u.pm / grp) * nN : 0) + u.pn; return true;
    }
};

struct InProjOrder {
    StaticOrder lat; int nlat, nctx_n, first_ctx_pm, skip_n, ntot, G, c;
    __host__ __device__ void init(int lat_rows, int ctx_rows, int N, int skip_n_, int G_, int c_) { lat.init(lat_rows, N, G_, c_); nlat = lat.nwg; skip_n = skip_n_; nctx_n = N / BM - skip_n_; first_ctx_pm = lat_rows / BM; ntot = nlat + (ctx_rows / BM) * nctx_n; G = G_; c = c_; }
    __host__ __device__ bool next(int i, Unit& u) const {
        const long L = (long)i * G + c; if (L >= ntot) return false;
        if (L < nlat) { StaticOrder t = lat; t.G = G; t.c = c; return t.next(i, u); }
        const int j = (int)L - nlat; u.pm = first_ctx_pm + j / nctx_n; u.pn = skip_n + j % nctx_n; u.pb = u.pn; return true;
    }
};

__device__ __forceinline__ unsigned cvt_pk_bf16(float lo, float hi) { unsigned r; asm volatile("v_cvt_pk_bf16_f32 %0, %1, %2" : "=v"(r) : "v"(lo), "v"(hi)); return r; }

struct EpiF32 {
    static constexpr bool PERM = false; static constexpr int WSCALE = 0x7f7f7f7f;
    float* C; int ldc;
    __device__ __forceinline__ void operator()(const f32x4 (&acc)[2][2][4][2], const Unit& u, int wr, int wc, int fr, int fq) const {
        const int row0 = u.pm * BM + wr * 64 + fr, col0 = u.pn * BM + wc * 32 + 4 * fq;
#pragma unroll
        for (int ai = 0; ai < 2; ++ai)
#pragma unroll
            for (int m = 0; m < 4; ++m) { float* rowp = C + (size_t)(row0 + ai * HALF + m * 16) * ldc + col0;
#pragma unroll
                for (int bj = 0; bj < 2; ++bj)
#pragma unroll
                    for (int n = 0; n < 2; ++n) *(f32x4*)(rowp + bj * HALF + n * 16) = acc[ai][bj][m][n]; }
    }
};
struct EpiBf16 {
    static constexpr bool PERM = true; static constexpr int WSCALE = 0x7f7f7f7f;
    bf16_t* O; int ldc; float scale;
    __device__ __forceinline__ void operator()(const f32x4 (&acc)[2][2][4][2], const Unit& u, int wr, int wc, int fr, int fq) const {
        const int row0 = u.pm * BM + wr * 64 + fr, col0 = u.pn * BM + wc * 32 + 8 * fq;
#pragma unroll
        for (int ai = 0; ai < 2; ++ai)
#pragma unroll
            for (int m = 0; m < 4; ++m) { bf16_t* rowp = O + (size_t)(row0 + ai * HALF + m * 16) * ldc + col0;
#pragma unroll
                for (int bj = 0; bj < 2; ++bj) { const f32x4 v0 = acc[ai][bj][m][0] * scale, v1 = acc[ai][bj][m][1] * scale;
                    u32x4 w; w.x = cvt_pk_bf16(v0[0], v0[1]); w.y = cvt_pk_bf16(v0[2], v0[3]); w.z = cvt_pk_bf16(v1[0], v1[1]); w.w = cvt_pk_bf16(v1[2], v1[3]);
                    *(u32x4*)(rowp + bj * HALF) = w; } }
    }
};
struct EpiSwiGLU {
    static constexpr bool PERM = true; static constexpr int WSCALE = 0x7f7f7f7f;
    bf16_t* H; int ldh;
    __device__ __forceinline__ void operator()(const f32x4 (&acc)[2][2][4][2], const Unit& u, int wr, int wc, int fr, int fq) const {
        const int row0 = u.pm * BM + wr * 64 + fr, col0 = u.pn * HALF + wc * 32 + 8 * fq;
#pragma unroll
        for (int ai = 0; ai < 2; ++ai)
#pragma unroll
            for (int m = 0; m < 4; ++m) { bf16_t* rowp = H + (size_t)(row0 + ai * HALF + m * 16) * ldh + col0;
                float h[8];
#pragma unroll
                for (int n = 0; n < 2; ++n)
#pragma unroll
                    for (int j = 0; j < 4; ++j) { const float g = acc[ai][0][m][n][j], up = acc[ai][1][m][n][j]; h[n * 4 + j] = g * up * __builtin_amdgcn_rcpf(1.0f + __expf(-g)); }
                u32x4 w; w.x = cvt_pk_bf16(h[0], h[1]); w.y = cvt_pk_bf16(h[2], h[3]); w.z = cvt_pk_bf16(h[4], h[5]); w.w = cvt_pk_bf16(h[6], h[7]);
                *(u32x4*)rowp = w; }
    }
};

struct EpiF8 {
    static constexpr bool PERM = true; static constexpr int WSCALE = 0x7f7f7f7f;
    unsigned char* O; int ldc; float scale;
    __device__ __forceinline__ void operator()(const f32x4 (&acc)[2][2][4][2], const Unit& u, int wr, int wc, int fr, int fq) const {
        const int row0 = u.pm * BM + wr * 64 + fr, col0 = u.pn * BM + wc * 32 + 8 * fq;
#pragma unroll
        for (int ai = 0; ai < 2; ++ai)
#pragma unroll
            for (int m = 0; m < 4; ++m) { unsigned char* rowp = O + (size_t)(row0 + ai * HALF + m * 16) * ldc + col0;
#pragma unroll
                for (int bj = 0; bj < 2; ++bj) { const f32x4 v0 = acc[ai][bj][m][0] * scale, v1 = acc[ai][bj][m][1] * scale;
                    unsigned w0 = __builtin_amdgcn_cvt_pk_fp8_f32(__builtin_amdgcn_fmed3f(v0[0], -448.f, 448.f), __builtin_amdgcn_fmed3f(v0[1], -448.f, 448.f), 0, false);
                    w0 = __builtin_amdgcn_cvt_pk_fp8_f32(__builtin_amdgcn_fmed3f(v0[2], -448.f, 448.f), __builtin_amdgcn_fmed3f(v0[3], -448.f, 448.f), w0, true);
                    unsigned w1 = __builtin_amdgcn_cvt_pk_fp8_f32(__builtin_amdgcn_fmed3f(v1[0], -448.f, 448.f), __builtin_amdgcn_fmed3f(v1[1], -448.f, 448.f), 0, false);
                    w1 = __builtin_amdgcn_cvt_pk_fp8_f32(__builtin_amdgcn_fmed3f(v1[2], -448.f, 448.f), __builtin_amdgcn_fmed3f(v1[3], -448.f, 448.f), w1, true);
                    *(u32x2*)(rowp + bj * HALF) = (u32x2){w0, w1}; } }
    }
};
__device__ __forceinline__ float clamp448(float x) { return __builtin_amdgcn_fmed3f(x, -448.0f, 448.0f); }
struct EpiSwiGLU8 {
    static constexpr bool PERM = true; static constexpr int WSCALE = 0x7a7a7a7a;
    unsigned char* H; int ldh; float in_scale, out_scale;
    __device__ __forceinline__ void operator()(const f32x4 (&acc)[2][2][4][2], const Unit& u, int wr, int wc, int fr, int fq) const {
        const int row0 = u.pm * BM + wr * 64 + fr, col0 = u.pn * HALF + wc * 32 + 8 * fq;
#pragma unroll
        for (int ai = 0; ai < 2; ++ai)
#pragma unroll
            for (int m = 0; m < 4; ++m) { unsigned char* rowp = H + (size_t)(row0 + ai * HALF + m * 16) * ldh + col0;
                float h[8];
#pragma unroll
                for (int n = 0; n < 2; ++n)
#pragma unroll
                    for (int j = 0; j < 4; ++j) { const float ga = acc[ai][0][m][n][j], ua = acc[ai][1][m][n][j];
                        const float sg = __builtin_amdgcn_rcpf(1.0f + __builtin_amdgcn_exp2f(-ga));
                        h[n * 4 + j] = clamp448(ga * ua * sg); }
                unsigned w0 = __builtin_amdgcn_cvt_pk_fp8_f32(h[0], h[1], 0, false); w0 = __builtin_amdgcn_cvt_pk_fp8_f32(h[2], h[3], w0, true);
                unsigned w1 = __builtin_amdgcn_cvt_pk_fp8_f32(h[4], h[5], 0, false); w1 = __builtin_amdgcn_cvt_pk_fp8_f32(h[6], h[7], w1, true);
                *(u32x2*)rowp = (u32x2){w0, w1}; }
    }
};

#ifndef F8_SCALE_WORD
#define F8_SCALE_WORD 0x7f7f7f7f
#endif
template <bool F8> struct FragT;
struct Frag16 { bf16x8 k[2]; };
template <> struct FragT<false> { typedef Frag16 T; };
template <> struct FragT<true> { typedef i32x8 T; };
__device__ __forceinline__ void frag_load(Frag16& d, const PG8_LAS unsigned char* p) { d.k[0] = *(const PG8_LAS bf16x8*)p; d.k[1] = *(const PG8_LAS bf16x8*)(p + 1024); }
__device__ __forceinline__ void frag_load(i32x8& d, const PG8_LAS unsigned char* p) { const i32x4 lo = *(const PG8_LAS i32x4*)p, hi = *(const PG8_LAS i32x4*)(p + 16); d = __builtin_shufflevector(lo, hi, 0, 1, 2, 3, 4, 5, 6, 7); }
template <int WSC> __device__ __forceinline__ f32x4 frag_mma(const Frag16& b, const Frag16& a, f32x4 c) { c = __builtin_amdgcn_mfma_f32_16x16x32_bf16(b.k[0], a.k[0], c, 0, 0, 0); return __builtin_amdgcn_mfma_f32_16x16x32_bf16(b.k[1], a.k[1], c, 0, 0, 0); }
template <int WSC> __device__ __forceinline__ f32x4 frag_mma(const i32x8& b, const i32x8& a, f32x4 c) {
#if F8_SCALE_WORD
    const int sc = F8_SCALE_WORD, scw = WSC; asm volatile("v_mfma_scale_f32_16x16x128_f8f6f4 %0, %1, %2, %0, %3, %4 op_sel_hi:[0,0,0]" : "+v"(c) : "v"(b), "v"(a), "v"(scw), "v"(sc));
#else
    asm volatile("v_mfma_f32_16x16x128_f8f6f4 %0, %1, %2, %0" : "+v"(c) : "v"(b), "v"(a));
#endif
    return c; }
#ifndef PG8_SP2
#define PG8_SP2 false
#endif
template <class Epi, class Sched, bool F8 = false, bool ALIGN_EPI = true, bool SP2 = PG8_SP2>
__device__ __forceinline__ void gemm_phase(PG8_LAS unsigned char* lds, const Gemm g, const Sched& S, const Epi& E) {
    int tid_ = threadIdx.x; asm volatile("" : "+v"(tid_));
    const int tid = tid_, wid = __builtin_amdgcn_readfirstlane(tid >> 6), lane = tid & 63, wr = wid >> 2, wc = wid & 3, fr = lane & 15, fq = lane >> 4;
    const int K = g.K, rowb = F8 ? K : 2 * K, nt = rowb / 128;
    unsigned voffA[2], voffB[2];
#pragma unroll
    for (int i = 0; i < 2; ++i) { int R, C; stage_rc(tid * 16 + i * 8192, R, C); const int Rb = Epi::PERM ? ((R & ~31) + perm32(R & 31)) : R;
        voffA[i] = (unsigned)(R * rowb + C * 2); voffB[i] = (unsigned)(Rb * rowb + C * 2); }
    const size_t kstep = (size_t)(BK * 2);
    const size_t hstep = (size_t)HALF * rowb;
    const size_t tstep = 2 * hstep;
    const unsigned ldsw = (unsigned)wid * 1024u;
    const int aoff = lds_byte(wr * 64 + fr, fq * (F8 ? 16 : 8)), boff = lds_byte(wc * 32 + fr, fq * (F8 ? 16 : 8));
#define PG8_SA(b, h) (((b) * 2 + (h)) * HTB)
#define PG8_SB(b, h) ((4 + (b) * 2 + (h)) * HTB)
#define PG8_STAGE(bufoff, gbase, voff) do { _Pragma("unroll") for (int _i = 0; _i < 2; ++_i) \
        __builtin_amdgcn_global_load_lds((const unsigned*)((const char*)(gbase) + (voff)[_i]), (PG8_LAS unsigned*)(lds + (bufoff) + ldsw + _i * 8192), 16, 0, 0); } while (0)
#define PG8_LDA(dst, b, h) do { _Pragma("unroll") for (int m = 0; m < 4; ++m) frag_load(dst[m], lds + PG8_SA(b, h) + aoff + m * 2048); } while (0)
#define PG8_LDB(dst, b, h) do { _Pragma("unroll") for (int n = 0; n < 2; ++n) frag_load(dst[n], lds + PG8_SB(b, h) + boff + n * 2048); } while (0)
#define PG8_MMA(ai, bj, At, Bt) do { __builtin_amdgcn_s_setprio(1); _Pragma("unroll") for (int m = 0; m < 4; ++m) _Pragma("unroll") for (int n = 0; n < 2; ++n) \
        acc[ai][bj][m][n] = frag_mma<Epi::WSCALE>(Bt[n], At[m], acc[ai][bj][m][n]); __builtin_amdgcn_s_setprio(0); } while (0)
#define PG8_WAIT_V(n) asm volatile("s_waitcnt vmcnt(" #n ")" ::: "memory")
#define PG8_WAIT_L(n) asm volatile("s_waitcnt lgkmcnt(" #n ")" ::: "memory")
#define PG8_BAR __builtin_amdgcn_s_barrier()
#define PG8_SCHED __builtin_amdgcn_sched_barrier(0)
    Unit cur, nxt; int ui = 0;
    if (!S.next(0, cur)) return;
    f32x4 acc[2][2][4][2];
#pragma unroll
    for (int a = 0; a < 2; ++a)
#pragma unroll
        for (int b = 0; b < 2; ++b)
#pragma unroll
            for (int m = 0; m < 4; ++m)
#pragma unroll
                for (int n = 0; n < 2; ++n) { acc[a][b][m][n] = (f32x4){0.f, 0.f, 0.f, 0.f}; if (F8) asm volatile("" : "+v"(acc[a][b][m][n])); }
    typename FragT<F8>::T At[4], B0[2], B1[2];
    const char* cA = (const char*)g.A + (size_t)cur.pm * tstep; const char* cB = (const char*)g.Bt + (size_t)cur.pb * tstep;
    if constexpr (SP2) {
        PG8_STAGE(PG8_SB(0, 0), cB, voffB); PG8_STAGE(PG8_SB(0, 1), cB + hstep, voffB); PG8_STAGE(PG8_SA(0, 0), cA, voffA); PG8_STAGE(PG8_SA(0, 1), cA + hstep, voffA);
        if (wr == 1) PG8_BAR;
        PG8_WAIT_V(2); PG8_BAR;
        PG8_STAGE(PG8_SB(1, 0), cB + kstep, voffB); PG8_STAGE(PG8_SA(1, 0), cA + kstep, voffA); PG8_STAGE(PG8_SB(1, 1), cB + hstep + kstep, voffB);
        PG8_WAIT_V(6); PG8_BAR;
    } else {
    PG8_STAGE(PG8_SB(0, 0), cB, voffB); PG8_STAGE(PG8_SA(0, 0), cA, voffA); PG8_STAGE(PG8_SB(0, 1), cB + hstep, voffB); PG8_STAGE(PG8_SA(0, 1), cA + hstep, voffA);
    if (wr == 1) PG8_BAR;
    PG8_WAIT_V(4); PG8_BAR;
    PG8_STAGE(PG8_SB(1, 0), cB + kstep, voffB); PG8_STAGE(PG8_SA(1, 0), cA + kstep, voffA); PG8_STAGE(PG8_SB(1, 1), cB + hstep + kstep, voffB);
    PG8_WAIT_V(6); PG8_BAR;
    }
    for (;;) {
        const bool has_next = S.next(ui + 1, nxt);
        const char* nA = has_next ? (const char*)g.A + (size_t)nxt.pm * tstep : cA; const char* nB = has_next ? (const char*)g.Bt + (size_t)nxt.pb * tstep : cB;
        for (int t = 0; t < nt; t += 2) {
            const bool last = (t == nt - 2);
            const char* a1 = cA + (size_t)(t + 1) * kstep;
            const char* a2 = last ? nA : cA + (size_t)(t + 2) * kstep; const char* b2 = last ? nB : cB + (size_t)(t + 2) * kstep;
            const char* a3 = a2 + kstep; const char* b3 = b2 + kstep;
            if constexpr (SP2) {
            PG8_LDB(B0, 0, 0); PG8_LDB(B1, 0, 1); PG8_SCHED; PG8_LDA(At, 0, 0); PG8_STAGE(PG8_SA(1, 1), a1 + hstep, voffA);
            PG8_WAIT_V(8); PG8_WAIT_L(0); PG8_BAR; PG8_MMA(0, 0, At, B0); PG8_MMA(0, 1, At, B1); PG8_BAR; PG8_SCHED;
            PG8_LDA(At, 0, 1); PG8_STAGE(PG8_SB(0, 0), b2, voffB); PG8_STAGE(PG8_SB(0, 1), b2 + hstep, voffB); PG8_STAGE(PG8_SA(0, 0), a2, voffA);
            PG8_WAIT_V(8); PG8_WAIT_L(0); PG8_BAR; PG8_MMA(1, 0, At, B0); PG8_MMA(1, 1, At, B1); PG8_BAR; PG8_SCHED;
            PG8_LDB(B0, 1, 0); PG8_LDB(B1, 1, 1); PG8_SCHED; PG8_LDA(At, 1, 0); PG8_STAGE(PG8_SA(0, 1), a2 + hstep, voffA);
            PG8_WAIT_V(8); PG8_WAIT_L(0); PG8_BAR; PG8_MMA(0, 0, At, B0); PG8_MMA(0, 1, At, B1); PG8_BAR; PG8_SCHED;
            PG8_LDA(At, 1, 1); PG8_STAGE(PG8_SB(1, 0), b3, voffB); PG8_STAGE(PG8_SB(1, 1), b3 + hstep, voffB); PG8_STAGE(PG8_SA(1, 0), a3, voffA);
            PG8_WAIT_V(8); PG8_WAIT_L(0); PG8_BAR; PG8_MMA(1, 0, At, B0); PG8_MMA(1, 1, At, B1); PG8_BAR; PG8_SCHED;
            } else {
            PG8_LDB(B0, 0, 0); PG8_SCHED; PG8_LDA(At, 0, 0); PG8_STAGE(PG8_SA(1, 1), a1 + hstep, voffA);
            PG8_WAIT_L(8); PG8_BAR; PG8_WAIT_L(0); PG8_MMA(0, 0, At, B0); PG8_BAR; PG8_SCHED;
            PG8_LDB(B1, 0, 1); PG8_STAGE(PG8_SB(0, 0), b2, voffB);
            PG8_BAR; PG8_WAIT_L(0); PG8_MMA(0, 1, At, B1); PG8_BAR;
            PG8_LDA(At, 0, 1); PG8_STAGE(PG8_SA(0, 0), a2, voffA);
            PG8_BAR; PG8_WAIT_L(0); PG8_MMA(1, 0, At, B0); PG8_BAR; PG8_SCHED;
            PG8_STAGE(PG8_SB(0, 1), b2 + hstep, voffB);
            PG8_WAIT_V(6); PG8_BAR; PG8_MMA(1, 1, At, B1); PG8_BAR;
            PG8_LDB(B0, 1, 0); PG8_SCHED; PG8_LDA(At, 1, 0); PG8_STAGE(PG8_SA(0, 1), a2 + hstep, voffA);
            PG8_WAIT_L(8); PG8_BAR; PG8_WAIT_L(0); PG8_MMA(0, 0, At, B0); PG8_BAR; PG8_SCHED;
            PG8_LDB(B1, 1, 1); PG8_STAGE(PG8_SB(1, 0), b3, voffB);
            PG8_BAR; PG8_WAIT_L(0); PG8_MMA(0, 1, At, B1); PG8_BAR;
            PG8_LDA(At, 1, 1); PG8_STAGE(PG8_SA(1, 0), a3, voffA);
            PG8_BAR; PG8_WAIT_L(0); PG8_MMA(1, 0, At, B0); PG8_BAR; PG8_SCHED;
            PG8_STAGE(PG8_SB(1, 1), b3 + hstep, voffB);
            PG8_WAIT_V(6); PG8_BAR; PG8_MMA(1, 1, At, B1); PG8_BAR;
            }
        }
        if constexpr (ALIGN_EPI) { if (wr == 0) PG8_BAR; }
        if (F8) asm volatile("s_nop 15\n\ts_nop 15" ::: "memory");
        E(acc, cur, wr, wc, fr, fq);
        if (!has_next) break;
#pragma unroll
        for (int a = 0; a < 2; ++a)
#pragma unroll
            for (int b = 0; b < 2; ++b)
#pragma unroll
                for (int m = 0; m < 4; ++m)
#pragma unroll
                    for (int n = 0; n < 2; ++n) { acc[a][b][m][n] = (f32x4){0.f, 0.f, 0.f, 0.f}; if (F8) asm volatile("" : "+v"(acc[a][b][m][n])); }
        cur = nxt; cA = nA; cB = nB; ++ui;
        if constexpr (ALIGN_EPI) { if (wr == 1) PG8_BAR; }
    }
    PG8_WAIT_V(0);
    if constexpr (!ALIGN_EPI) { if (wr == 0) PG8_BAR; }
    PG8_BAR;
#undef PG8_SA
#undef PG8_SB
#undef PG8_STAGE
#undef PG8_LDA
#undef PG8_LDB
#undef PG8_MMA
#undef PG8_WAIT_V
#undef PG8_WAIT_L
#undef PG8_BAR
#undef PG8_SCHED
}
}

constexpr int NWAVES = 8, NTHR = 512;
constexpr int D = 1024, NB = 16, T = 2048, TC = 256;
constexpr int M_LAT = NB * T, M_CTX = NB * TC, M_ALL = M_LAT + M_CTX;
constexpr int INW = 3328, RW_IN = 1760;
constexpr int C_R = 0, C_GG = 512, C_Q = 1024, C_K = 1280, C_V = 1792, C_WDF = 2304, C_WDB = 2336, C_ADF = 2368, C_ADB = 2400, C_GD = 2432;
constexpr int C_KG = 2528, C_VG = 2784, C_GADF = 3296, C_GADB = 3312;
constexpr int MU_SHIFT = 768;
__host__ __device__ constexpr int zcol_of_src(int n) {
    return n < 512 ? n : n < 1760 ? n + 768 : n < 2016 ? n - 736 : n < 2784 ? n + 512 : n < 3296 ? n - 2272 : n; }
constexpr int NE = 16, FF = 2816, CAP = 256;
constexpr float LN_EPS = 1e-5f, GN_EPS = 64e-5f, GLA_EPS = 1e-5f;
constexpr float DN_ALPHA = 1.189207115002721f;
enum { I_X = 0, I_C, I_CTX, I_CCTX, I_ADAW, I_ADAB, I_WIN, I_MU, I_W0, I_W2, I_A0, I_A2, I_G2, I_KK, I_KA, I_RK, I_GNW, I_GNB, I_GLA2, I_GLAB, I_GLNW, I_WOUT,
       I_LN1G, I_LN1B, I_RTW, I_EXG, I_EXU, I_EXD, I_LN2G, I_LN2B, N_IN };

constexpr size_t MiB = 1u << 20;
constexpr size_t WS_CTL = 0, CTL_ZERO_BYTES = 1 * MiB;
constexpr size_t WS_MOD = 1 * MiB;
constexpr size_t WS_WIN = 2 * MiB;
constexpr size_t WS_WOUT = 9 * MiB;
constexpr size_t WS_G2T = 11 * MiB;
constexpr size_t WS_WGU = 12 * MiB;
constexpr size_t WS_WD = 100 * MiB;
constexpr size_t WS_H0 = 276 * MiB;
constexpr size_t WS_O = 276 * MiB;
constexpr size_t WS_Z = 404 * MiB;
constexpr size_t WS_CB = 638 * MiB;
constexpr size_t WS_MIX = 640 * MiB;
constexpr size_t WS_PROJ = 276 * MiB;
constexpr size_t WS_XIN = 276 * MiB;
constexpr size_t WS_HH = 340 * MiB;
constexpr size_t WS_YE = 516 * MiB;
constexpr size_t WS_X1 = 580 * MiB;
constexpr size_t WS_H2 = 644 * MiB;
constexpr size_t WS_AFF = 676 * MiB;
constexpr size_t WS_SELPOS = 678 * MiB;
constexpr size_t WS_GATE = 680 * MiB;
constexpr size_t WS_END = 704 * MiB;
#ifndef INPROJ_F8
#define INPROJ_F8 0
#endif
constexpr float HA_SCALE = 8.0f, WIN_SCALE = 256.0f;
#ifndef OUTPROJ_F8
#define OUTPROJ_F8 1
#endif
constexpr float MIX_SCALE = 8.0f, WOUT_SCALE = 256.0f;
constexpr float XIN_L = 1.44269504088896f;
constexpr float W1_SCALE = 32.0f, W2_SCALE = 64.0f, H_SCALE = XIN_L * XIN_L, YE_SCALE = 16.0f;
constexpr int CW_TMO = 0;
constexpr int CW_BAR = 4096;

constexpr int RING_BYTES = 131072;
constexpr int LDSCTL_OFF = RING_BYTES, MISC_OFF = LDSCTL_OFF + 320;
constexpr int LDS_BYTES = 147456;

#define LAS __attribute__((address_space(3)))
typedef unsigned short bf16;
typedef unsigned v4u __attribute__((ext_vector_type(4)));
typedef unsigned v2u __attribute__((ext_vector_type(2)));
typedef float f32x4 __attribute__((ext_vector_type(4)));
typedef float f32x2 __attribute__((ext_vector_type(2)));
typedef short bf16x8 __attribute__((ext_vector_type(8)));
#define RLX_AGENT __ATOMIC_RELAXED, __HIP_MEMORY_SCOPE_AGENT
typedef __bf16 hwbf16x2 __attribute__((ext_vector_type(2)));
__device__ __forceinline__ unsigned pk2(float lo, float hi) { const f32x2 v = {lo, hi}; return __builtin_bit_cast(unsigned, __builtin_convertvector(v, hwbf16x2)); }
__device__ __forceinline__ unsigned f2bf(float f) { return pk2(f, f) & 0xffffu; }
__device__ __forceinline__ float bflo(unsigned w) { return __builtin_bit_cast(float, w << 16); }
__device__ __forceinline__ float bfhi(unsigned w) { return __builtin_bit_cast(float, w & 0xffff0000u); }
__device__ __forceinline__ float bf1(bf16 h) { return __builtin_bit_cast(float, ((unsigned)h) << 16); }
__device__ __forceinline__ void unpack4_fp8(unsigned w, float* f) { f[0] = __builtin_amdgcn_cvt_f32_fp8(w, 0); f[1] = __builtin_amdgcn_cvt_f32_fp8(w, 1); f[2] = __builtin_amdgcn_cvt_f32_fp8(w, 2); f[3] = __builtin_amdgcn_cvt_f32_fp8(w, 3); }
__device__ __forceinline__ void unpack8(const v4u w, float* f) { f[0] = bflo(w.x); f[1] = bfhi(w.x); f[2] = bflo(w.y); f[3] = bfhi(w.y); f[4] = bflo(w.z); f[5] = bfhi(w.z); f[6] = bflo(w.w); f[7] = bfhi(w.w); }
template <int CTRL> __device__ __forceinline__ float dppmov(float v) { return __builtin_bit_cast(float, __builtin_amdgcn_update_dpp(0, __builtin_bit_cast(int, v), CTRL, 0xF, 0xF, true)); }
__device__ __forceinline__ float red4(float x) { x += dppmov<0xB1>(x); x += dppmov<0x4E>(x); return x; }
__device__ __forceinline__ float red8(float x) { x = red4(x); x += dppmov<0x141>(x); return x; }
__device__ __forceinline__ float red16(float x) { x = red8(x); x += dppmov<0x140>(x); return x; }
__device__ __forceinline__ float wave_sum(float v) {
#pragma unroll
    for (int o = 1; o < 64; o <<= 1) v += __shfl_xor(v, o);
    return v;
}
__device__ __forceinline__ float wave_sum_dpp(float x) {
    x += dppmov<0xB1>(x); x += dppmov<0x4E>(x); x += dppmov<0x124>(x); x += dppmov<0x128>(x);
    x += __builtin_bit_cast(float, __builtin_amdgcn_update_dpp(0, __builtin_bit_cast(int, x), 0x142, 0xA, 0xF, false));
    x += __builtin_bit_cast(float, __builtin_amdgcn_update_dpp(0, __builtin_bit_cast(int, x), 0x143, 0xC, 0xF, false));
    return __builtin_bit_cast(float, __builtin_amdgcn_readlane(__builtin_bit_cast(int, x), 63));
}
__device__ __forceinline__ float fexp(float x) { return __builtin_amdgcn_exp2f(x * 1.44269504088896f); }
__device__ __forceinline__ float fsigmoid(float x) { return __builtin_amdgcn_rcpf(1.0f + fexp(-x)); }
__device__ __forceinline__ float sigmoidf_(float x) { return 1.0f / (1.0f + expf(-x)); }

#define XB_TMO      128
#define XB_XCNT(j)  (256  + 64 * (j))
#define XB_XSUB(j)  (1280 + 64 * (j))
#define XB_XGEN(j)  (2304 + 64 * (j))
#define XB_TOP      3328
#define XB_TOPGEN   3392
#define XCD_BAR_WORDS 3456
#define XB_SPIN_CAP (1u << 18)
__device__ __forceinline__ unsigned xb_ld(unsigned* p)              { return __hip_atomic_load(p, __ATOMIC_RELAXED, __HIP_MEMORY_SCOPE_AGENT); }
__device__ __forceinline__ unsigned xb_add(unsigned* p, unsigned v) { return __hip_atomic_fetch_add(p, v, __ATOMIC_RELAXED, __HIP_MEMORY_SCOPE_AGENT); }
__device__ __forceinline__ unsigned xb_xcc_id() { return (unsigned)__builtin_amdgcn_s_getreg((3 << 11) | 20) & 0xFu; }
#define XB_SPIN(cond, bar) do { unsigned _sp = 0; while (cond) { __builtin_amdgcn_s_sleep(1); \
    if ((++_sp & 255u) == 0u) { if (xb_ld(&(bar)[XB_TMO])) break; if (_sp > XB_SPIN_CAP) { atomicAdd(&(bar)[XB_TMO], 1u); break; } } } } while (0)
struct XcdBarrier { unsigned* bar; unsigned x; volatile LAS unsigned* st; };
__device__ __forceinline__ XcdBarrier xcd_barrier_post(unsigned* bar, volatile LAS unsigned* st) {
    XcdBarrier b; b.bar = bar; b.x = xb_xcc_id(); b.st = st;
    if (threadIdx.x == 0) (void)xb_add(&bar[XB_XCNT(b.x)], 1u);
    return b;
}
__device__ __forceinline__ void xcd_barrier_complete(unsigned* bar, unsigned x, unsigned& nloc, unsigned& nx) {
    const unsigned G = gridDim.x * gridDim.y * gridDim.z;
    unsigned sum, cnt, mine, sp = 0u;
    for (;;) {
        sum = 0u; cnt = 0u; mine = 0u;
#pragma unroll
        for (unsigned j = 0; j < 16; ++j) { const unsigned c = xb_ld(&bar[XB_XCNT(j)]); sum += c; cnt += (c > 0u) ? 1u : 0u; mine = (j == x) ? c : mine; }
        if (sum == G) break;
        __builtin_amdgcn_s_sleep(1);
        if ((++sp & 255u) == 0u) { if (xb_ld(&bar[XB_TMO])) break; if (sp > XB_SPIN_CAP) { atomicAdd(&bar[XB_TMO], 1u); break; } }
    }
    nloc = mine > 0u ? mine : 1u; nx = cnt > 0u ? cnt : 1u;
}
__device__ __forceinline__ void xcd_barrier(const XcdBarrier& b) {
    asm volatile("s_waitcnt vmcnt(0)" ::: "memory");
    __syncthreads();
    if (threadIdx.x == 0) {
        unsigned* bar = b.bar;
        __builtin_amdgcn_s_waitcnt(0);
        unsigned nloc = b.st[0], nx = b.st[1];
        if (nloc == 0u) { xcd_barrier_complete(bar, b.x, nloc, nx); b.st[0] = nloc; b.st[1] = nx; }
        const unsigned old = xb_add(&bar[XB_XSUB(b.x)], 1u);
        const unsigned gen = old / nloc;
        if (old + 1u == (gen + 1u) * nloc) {
            __builtin_amdgcn_fence(__ATOMIC_RELEASE, "agent");
            asm volatile("s_waitcnt vmcnt(0)" ::: "memory");
            const unsigned og = xb_add(&bar[XB_TOP], 1u);
            const unsigned tg = og / nx;
            if (og + 1u == (tg + 1u) * nx) xb_add(&bar[XB_TOPGEN], 1u);
            else XB_SPIN(xb_ld(&bar[XB_TOPGEN]) == tg, bar);
            __builtin_amdgcn_fence(__ATOMIC_ACQUIRE, "agent");
            xb_add(&bar[XB_XGEN(b.x)], 1u);
            asm volatile("s_waitcnt vmcnt(0)" ::: "memory");
        } else {
            XB_SPIN(xb_ld(&bar[XB_XGEN(b.x)]) == gen, bar);
            __builtin_amdgcn_fence(__ATOMIC_ACQUIRE, "agent");
            asm volatile("s_waitcnt vmcnt(0)" ::: "memory");
        }
    }
    __syncthreads();
}

struct Args { const float* in[N_IN]; float* out; unsigned char* ws; int ph_lo, ph_hi; };
struct Frame {
    LAS unsigned char* lds;
    int tid, lane, wave, G, bid;
    const float* const* in; float* out; unsigned char* ws;
};
#define WSP(T_, off) ((T_*)(F.ws + (off)))

__device__ __forceinline__ int zrow_lat(int b, int t) { return b * T + t; }
__device__ __forceinline__ int zrow_ctx(int b, int t) { return M_LAT + b * TC + t; }

struct Nbr { int r[4]; float m[4]; float coef; };
__device__ __forceinline__ Nbr nbr_of(int row) {
    Nbr n;
    if (row < M_LAT) { const int t = row & (T - 1), gx = t & 63, gy = t >> 6;
        const bool l = gx > 0, r = gx < 63, u = gy > 0, d = gy < 31;
        n.r[0] = l ? row - 1 : row; n.r[1] = r ? row + 1 : row; n.r[2] = u ? row - 64 : row; n.r[3] = d ? row + 64 : row;
        n.m[0] = l ? 1.f : 0.f; n.m[1] = r ? 1.f : 0.f; n.m[2] = u ? 1.f : 0.f; n.m[3] = d ? 1.f : 0.f; n.coef = 0.25f;
    } else { const int t = (row - M_LAT) & (TC - 1); const bool l = t > 0, r = t < TC - 1;
        n.r[0] = l ? row - 1 : row; n.r[1] = r ? row + 1 : row; n.r[2] = row; n.r[3] = row;
        n.m[0] = l ? 1.f : 0.f; n.m[1] = r ? 1.f : 0.f; n.m[2] = 0.f; n.m[3] = 0.f; n.coef = 0.5f; }
    return n;
}
__device__ __forceinline__ void shift8(const v4u c, const v4u* nb, const Nbr& n, const float* mu8, float* out) {
    float zc[8], acc[8], t[8]; unpack8(c, zc);
#pragma unroll
    for (int e = 0; e < 8; ++e) acc[e] = 0.f;
#pragma unroll
    for (int q = 0; q < 4; ++q) { unpack8(nb[q], t);
#pragma unroll
        for (int e = 0; e < 8; ++e) acc[e] += n.m[q] * t[e]; }
#pragma unroll
    for (int e = 0; e < 8; ++e) out[e] = zc[e] + (n.coef * acc[e] - zc[e]) * mu8[e];
}

__device__ __forceinline__ void p0_mod_item(Frame& F, int item) {
    LAS float* S = (LAS float*)F.lds;
    LAS float* RED = S + 17 * 1024;
    const float* c = F.in[I_C]; const float* cc = F.in[I_CCTX]; const float* W = F.in[I_ADAW]; const float* bias = F.in[I_ADAB];
    const int kg = F.tid >> 5, col = F.tid & 31, n0 = item * 32;
    float wall[64];
#pragma unroll
    for (int q = 0; q < 64; ++q) wall[q] = W[(size_t)(kg * 64 + q) * (6 * D) + n0 + col];
    for (int i = F.tid; i < 17 * 1024; i += NTHR) { const float v = (i < 16 * 1024) ? c[i] : cc[i - 16 * 1024]; S[i] = v * fsigmoid(v); }
    __syncthreads();
    float acc[17];
#pragma unroll
    for (int r = 0; r < 17; ++r) acc[r] = 0.f;
#pragma unroll
    for (int k8 = 0; k8 < 8; ++k8) { const int k = kg * 64 + 8 * k8;
#pragma unroll
        for (int r = 0; r < 17; ++r) { const f32x4 s0 = *(const LAS f32x4*)(S + r * 1024 + k), s1 = *(const LAS f32x4*)(S + r * 1024 + k + 4);
            acc[r] += (s0.x * wall[8 * k8] + s0.y * wall[8 * k8 + 1]) + (s0.z * wall[8 * k8 + 2] + s0.w * wall[8 * k8 + 3]) + (s1.x * wall[8 * k8 + 4] + s1.y * wall[8 * k8 + 5]) + (s1.z * wall[8 * k8 + 6] + s1.w * wall[8 * k8 + 7]); }
    }
#pragma unroll
    for (int r = 0; r < 17; ++r) RED[(kg * 17 + r) * 32 + col] = acc[r];
    __syncthreads();
    float* mod = WSP(float, WS_MOD);
    for (int i = F.tid; i < 17 * 32; i += NTHR) { const int r = i >> 5, cl = i & 31; float s = bias[n0 + cl];
#pragma unroll
        for (int g = 0; g < 16; ++g) s += RED[(g * 17 + r) * 32 + cl];
        mod[r * (6 * D) + n0 + cl] = s; }
    __syncthreads();
}
__device__ __forceinline__ void p0_transpose_item(const float* W, int N, int K, bf16* WT, int drow0, int k0, int n0, LAS float* scr, int lane) {
#pragma unroll 8
    for (int i = 0; i < 32; ++i) { const int kk = 2 * i + (lane >> 5); scr[kk * 33 + (lane & 31)] = W[(size_t)(k0 + kk) * N + n0 + (lane & 31)]; }
    asm volatile("s_waitcnt vmcnt(0) lgkmcnt(0)" ::: "memory");
    const int c = lane & 7;
#pragma unroll
    for (int j = 0; j < 4; ++j) { const int n = (lane >> 3) + 8 * j; const LAS float* s = scr + (8 * c) * 33 + n;
        v4u o; o.x = pk2(s[0 * 33], s[1 * 33]); o.y = pk2(s[2 * 33], s[3 * 33]); o.z = pk2(s[4 * 33], s[5 * 33]); o.w = pk2(s[6 * 33], s[7 * 33]);
        *(v4u*)(WT + (size_t)(drow0 + n) * K + k0 + 8 * c) = o; }
    asm volatile("s_waitcnt lgkmcnt(0)" ::: "memory");
}
__device__ __forceinline__ float clamp448f(float x) { return __builtin_amdgcn_fmed3f(x, -448.0f, 448.0f); }
__device__ __forceinline__ unsigned pk4_fp8(float a, float b, float c, float d) { unsigned w = __builtin_amdgcn_cvt_pk_fp8_f32(a, b, 0, false); return __builtin_amdgcn_cvt_pk_fp8_f32(c, d, w, true); }
__device__ __forceinline__ void p0_transpose_item_f8(const float* W, int N, int K, unsigned char* WT, int drow0, int k0, int n0, float scale, LAS float* scr, int lane) {
#pragma unroll 8
    for (int i = 0; i < 32; ++i) { const int kk = 2 * i + (lane >> 5); scr[kk * 33 + (lane & 31)] = W[(size_t)(k0 + kk) * N + n0 + (lane & 31)]; }
    asm volatile("s_waitcnt vmcnt(0) lgkmcnt(0)" ::: "memory");
    const int n = lane & 31, hf = lane >> 5; const LAS float* sp = scr + (32 * hf) * 33 + n;
    unsigned w[8];
#pragma unroll
    for (int q = 0; q < 8; ++q) w[q] = pk4_fp8(sp[(4 * q) * 33] * scale, sp[(4 * q + 1) * 33] * scale, sp[(4 * q + 2) * 33] * scale, sp[(4 * q + 3) * 33] * scale);
    v4u* dst = (v4u*)(WT + (size_t)(drow0 + n) * K + k0 + 32 * hf);
    dst[0] = (v4u){w[0], w[1], w[2], w[3]}; dst[1] = (v4u){w[4], w[5], w[6], w[7]};
    asm volatile("s_waitcnt lgkmcnt(0)" ::: "memory");
}
__device__ __forceinline__ void p0_prologue(Frame& F) {
    __syncthreads();
    for (int it = F.bid; it < 192; it += F.G) p0_mod_item(F, it);
    __syncthreads();
    LAS float* scr = (LAS float*)(F.lds + F.wave * 16384);
    const int gw = F.bid * NWAVES + F.wave, NGW = F.G * NWAVES;
#ifndef SIDEJOB
#define SIDEJOB 1
#endif
    constexpr int I_IN = (D / 64) * (INW / 32), I_OUT = (D / 64) * (D / 32), I_GU = (D / 64) * (FF / 32), I_DN = (FF / 64) * (D / 32);
    constexpr int NITEMS = I_IN + I_OUT + (SIDEJOB ? 0 : NE * (2 * I_GU + I_DN));
    for (int it = gw; it < NITEMS; it += NGW) {
        int r = it;
        if (r < I_IN) { const int nblk = INW / 32, kb = r / nblk, nb = r % nblk;
#if INPROJ_F8
            p0_transpose_item_f8(F.in[I_WIN], INW, D, WSP(unsigned char, WS_WIN), zcol_of_src(32 * nb), 64 * kb, 32 * nb, WIN_SCALE, scr, F.lane);
#else
            p0_transpose_item(F.in[I_WIN], INW, D, WSP(bf16, WS_WIN), zcol_of_src(32 * nb), 64 * kb, 32 * nb, scr, F.lane);
#endif
            continue; } r -= I_IN;
        if (r < I_OUT) { const int nblk = D / 32, kb = r / nblk, nb = r % nblk;
#if OUTPROJ_F8
            p0_transpose_item_f8(F.in[I_WOUT], D, D, WSP(unsigned char, WS_WOUT), 32 * nb, 64 * kb, 32 * nb, WOUT_SCALE, scr, F.lane);
#else
            p0_transpose_item(F.in[I_WOUT], D, D, WSP(bf16, WS_WOUT), 32 * nb, 64 * kb, 32 * nb, scr, F.lane);
#endif
            continue; } r -= I_OUT;
        const int e = r / (2 * I_GU + I_DN); r -= e * (2 * I_GU + I_DN);
        if (r < 2 * I_GU) { const int up = r >= I_GU ? 1 : 0; r -= up * I_GU; const int nblk = FF / 32, kb = r / nblk, nb = r % nblk, n0 = 32 * nb;
            const float* src = (up ? F.in[I_EXU] : F.in[I_EXG]) + (size_t)e * D * FF;
            const int drow = e * (2 * FF) + 256 * (n0 >> 7) + 128 * up + (n0 & 127);
            p0_transpose_item_f8(src, FF, D, WSP(unsigned char, WS_WGU), drow, 64 * kb, n0, W1_SCALE, scr, F.lane); continue; }
        r -= 2 * I_GU;
        { const int nblk = D / 32, kb = r / nblk, nb = r % nblk;
          p0_transpose_item_f8(F.in[I_EXD] + (size_t)e * FF * D, D, FF, WSP(unsigned char, WS_WD), e * D + 32 * nb, 64 * kb, 32 * nb, W2_SCALE, scr, F.lane); }
    }
    { const float* g2 = F.in[I_G2]; bf16* g2t = WSP(bf16, WS_G2T);
      for (int i = F.bid * NTHR + F.tid; i < 512 * 96; i += F.G * NTHR) { const int n = i / 96, k = i % 96; g2t[i] = (bf16)f2bf(g2[k * 512 + n]); } }
}

__device__ __forceinline__ const float* p1_row(Frame& F, int m) { return m < M_LAT ? F.in[I_X] + (size_t)m * D : F.in[I_CTX] + (size_t)(m - M_LAT) * D; }
__device__ __forceinline__ void p1_ln_mod(Frame& F) {
    const int gw = F.bid * NWAVES + F.wave, NGW = F.G * NWAVES;
    const float* mod = WSP(float, WS_MOD); bf16* H0 = WSP(bf16, WS_H0);
    f32x4 nx[4];
    if (gw < M_ALL) { const f32x4* xr = (const f32x4*)p1_row(F, gw) + F.lane;
#pragma unroll
        for (int j = 0; j < 4; ++j) nx[j] = xr[64 * j]; }
    for (int m = gw; m < M_ALL; m += NGW) {
        const int mr = m < M_LAT ? (m >> 11) : 16;
        const f32x4* sh = (const f32x4*)(mod + (size_t)mr * 6 * D) + F.lane; const f32x4* sc = (const f32x4*)(mod + (size_t)mr * 6 * D + D) + F.lane;
        f32x4 shv[4], scv[4];
#pragma unroll
        for (int j = 0; j < 4; ++j) { shv[j] = sh[64 * j]; scv[j] = sc[64 * j]; }
        f32x4 v[4]; float s = 0.f;
#pragma unroll
        for (int j = 0; j < 4; ++j) { v[j] = nx[j]; s += (v[j].x + v[j].y) + (v[j].z + v[j].w); }
        { const f32x4* xr = (const f32x4*)p1_row(F, m + NGW < M_ALL ? m + NGW : m) + F.lane;
#pragma unroll
            for (int j = 0; j < 4; ++j) nx[j] = xr[64 * j]; }
        const float mean = wave_sum_dpp(s) * (1.f / D); float s2 = 0.f;
#pragma unroll
        for (int j = 0; j < 4; ++j) { v[j] = v[j] - mean; s2 += (v[j].x * v[j].x + v[j].y * v[j].y) + (v[j].z * v[j].z + v[j].w * v[j].w); }
        const float rstd = __builtin_amdgcn_rsqf(wave_sum_dpp(s2) * (1.f / D) + LN_EPS);
#if INPROJ_F8
        unsigned* o4 = (unsigned*)((unsigned char*)H0 + (size_t)m * D) + F.lane; const float rs8 = rstd * HA_SCALE;
#pragma unroll
        for (int j = 0; j < 4; ++j) { const f32x4 h = v[j] * rs8 * (scv[j] + 1.0f) + shv[j] * HA_SCALE;
            o4[64 * j] = pk4_fp8(clamp448f(h.x), clamp448f(h.y), clamp448f(h.z), clamp448f(h.w)); }
#else
        unsigned long long* o8 = (unsigned long long*)(H0 + (size_t)m * D) + F.lane;
#pragma unroll
        for (int j = 0; j < 4; ++j) { const f32x4 h = v[j] * rstd * (scv[j] + 1.0f) + shv[j];
            o8[64 * j] = (unsigned long long)pk2(h.x, h.y) | ((unsigned long long)pk2(h.z, h.w) << 32); }
#endif
    }
}

__device__ __forceinline__ int scan_base_row(int n, int dir, int b) { if (n < 16) { const int ci = dir ? 15 - n : n; return zrow_ctx(b, 16 * ci); } const int m = n - 16, li = dir ? 127 - m : m; return zrow_lat(b, 16 * li); }
__device__ __forceinline__ float dot4(const f32x4 a, const f32x4 b) { return (a.x * b.x + a.y * b.y) + (a.z * b.z + a.w * b.w); }
constexpr int SC_ALD = 72, SC_WLD = 40;
__device__ __forceinline__ float pair_red16(const float a0, const float a1, const bool odd) {
    float t = odd ? a1 : a0; const float u = odd ? a0 : a1;
    t += dppmov<0xB1>(u); t += dppmov<0x4E>(t); t += dppmov<0x124>(t); t += dppmov<0x128>(t);
    return t;
}
__device__ __forceinline__ float opq(float x) { asm("" : "+v"(x)); return x; }
struct S8 { float a[8]; };
template <bool LAT>
__device__ __forceinline__ void scan_steps(const LAS float* VEC, LAS float* YB, const int dir, const int kg, const int row0, S8& S) {
    const int sstr = dir ? -64 : 64; const bool odd = (kg & 1) != 0; const int kh2 = kg >> 1;
    const LAS float* p0 = VEC + (dir ? 15 * 64 : 0) + 4 * kg;
    const LAS float* pv = VEC + 5 * 1024 + (dir ? 15 * 64 : 0) + row0;
    f32x4 w4 = *(const LAS f32x4*)p0, ka4 = *(const LAS f32x4*)(p0 + 2048), kh4 = *(const LAS f32x4*)(p0 + 3072), r4 = *(const LAS f32x4*)(p0 + 4096);
    f32x2 v2 = *(const LAS f32x2*)pv;
    f32x4 kkn = *(const LAS f32x4*)(p0 + 1024);
    float skp;
    { float d0 = S.a[0] * kkn[0], d1 = S.a[4] * kkn[0];
#pragma unroll
      for (int e = 1; e < 4; ++e) { d0 = __builtin_fmaf(S.a[e], kkn[e], d0); d1 = __builtin_fmaf(S.a[4 + e], kkn[e], d1); }
      skp = pair_red16(d0, d1, odd); }
    kkn = *(const LAS f32x4*)(p0 + sstr + 1024);
    float keepA = 0.f, keepB = 0.f;
#pragma unroll
    for (int s = 0; s < 16; ++s) {
        const LAS float* pn = p0 + (s + 1) * sstr;
        f32x4 w4n, ka4n, kh4n, r4n, kk2; f32x2 v2n;
        if (s < 15) { w4n = *(const LAS f32x4*)pn; ka4n = *(const LAS f32x4*)(pn + 2048); kh4n = *(const LAS f32x4*)(pn + 3072); if (LAT) r4n = *(const LAS f32x4*)(pn + 4096); v2n = *(const LAS f32x2*)(pv + (s + 1) * sstr); }
        if (s < 14) kk2 = *(const LAS f32x4*)(pn + sstr + 1024);
        const float sk0 = -dppmov<0xA0>(skp), sk1 = -dppmov<0xF5>(skp);
        float d0 = 0.f, d1 = 0.f, y0 = 0.f, y1 = 0.f;
#pragma unroll
        for (int e = 0; e < 4; ++e) {
            float a = opq(S.a[e] * w4[e]); a = __builtin_fmaf(ka4[e], sk0, a); a = opq(__builtin_fmaf(kh4[e], v2.x, a)); S.a[e] = a;
            float c = opq(S.a[4 + e] * w4[e]); c = __builtin_fmaf(ka4[e], sk1, c); c = opq(__builtin_fmaf(kh4[e], v2.y, c)); S.a[4 + e] = c;
            if (s < 15) { d0 = __builtin_fmaf(a, kkn[e], d0); d1 = __builtin_fmaf(c, kkn[e], d1); }
            if (LAT) { y0 = __builtin_fmaf(a, r4[e], y0); y1 = __builtin_fmaf(c, r4[e], y1); }
        }
        if (s < 15) skp = pair_red16(d0, d1, odd);
        if (LAT) { const float ty = pair_red16(y0, y1, odd);
            if ((s & 1) == 0) keepA = (kh2 == (s >> 1)) ? ty : keepA; else keepB = (kh2 == (s >> 1)) ? ty : keepB; }
        if (s < 15) { w4 = w4n; ka4 = ka4n; kh4 = kh4n; if (LAT) r4 = r4n; v2 = v2n; }
        if (s < 14) kkn = kk2;
    }
    if (LAT) { const int st = 2 * kh2; const int iA = dir ? 15 - st : st, iB = dir ? 14 - st : st + 1; const int rr = row0 + (odd ? 1 : 0);
        YB[iA * 64 + rr] = keepA; YB[iB * 64 + rr] = keepB; }
}
constexpr int CV_GU_ITEMS = NE * 2 * (D / 64) * (FF / 32);
constexpr int CV_DN_ITEMS = NE * (FF / 64) * (D / 32);
constexpr int CV_ITEMS = CV_GU_ITEMS + CV_DN_ITEMS;
#ifndef CV_SCALED_CVT
#define CV_SCALED_CVT 1
#endif
struct CvItem { const float* src; unsigned char* dst; int N; int loff; int doff; float scale; int nb, nblk, step, jump; };
__device__ __forceinline__ CvItem cv_item(Frame& F, int it, int lane) {
    const int n = lane & 31, hf = lane >> 5; CvItem c;
    if (it < CV_GU_ITEMS) { const int per_e = 2 * (D / 64) * (FF / 32); const int e = it / per_e; int r = it - e * per_e; const int up = r >= per_e / 2 ? 1 : 0; r -= up * (per_e / 2);
        const int nblk = FF / 32, kb = r / nblk, nb = r % nblk, n0 = 32 * nb, k0 = 64 * kb;
        c.src = (up ? F.in[I_EXU] : F.in[I_EXG]) + (size_t)e * D * FF + (size_t)k0 * FF + n0;
        c.dst = WSP(unsigned char, WS_WGU) + (size_t)(e * (2 * FF) + 256 * (n0 >> 7) + 128 * up + (n0 & 127)) * D + k0; c.N = FF; c.scale = W1_SCALE;
        c.loff = 32 * hf * FF + n; c.doff = n * D + 32 * hf; c.nb = nb; c.nblk = nblk; c.step = 32 * D; c.jump = 128 * D;
    } else { int r = it - CV_GU_ITEMS; const int per_e = (FF / 64) * (D / 32); const int e = r / per_e; r -= e * per_e; const int nblk = D / 32, kb = r / nblk, nb = r % nblk, n0 = 32 * nb, k0 = 64 * kb;
        c.src = F.in[I_EXD] + (size_t)e * FF * D + (size_t)k0 * D + n0;
        c.dst = WSP(unsigned char, WS_WD) + (size_t)(e * D + n0) * FF + k0; c.N = D; c.scale = W2_SCALE;
        c.loff = 32 * hf * D + n; c.doff = n * FF + 32 * hf; c.nb = nb; c.nblk = nblk; c.step = 32 * FF; c.jump = 0; }
    return c;
}
__device__ __forceinline__ void cv_item_next(Frame& F, CvItem& c, int it, int lane) {
    const int nb = c.nb + 1;
    if (nb == c.nblk) { c = cv_item(F, it, lane); return; }
    c.nb = nb; c.src += 32; c.dst += c.step + ((nb & 3) == 0 ? c.jump : 0);
}
struct CvRegs { float v[32]; };
__device__ __forceinline__ void cv_issue(const CvItem& c, CvRegs& R) {
    const char* base = (const char*)c.src; const unsigned offb = (unsigned)c.loff * 4u;
#pragma unroll
    for (int i = 0; i < 32; ++i) { R.v[i] = __builtin_nontemporal_load((const float*)(base + offb)); base += (size_t)c.N * 4; }
}
typedef short cv_s2 __attribute__((ext_vector_type(2)));
__device__ __forceinline__ unsigned pk4_fp8_scaled(float a, float b, float c_, float d, float inv_scale) {
    cv_s2 r = {0, 0}; r = __builtin_amdgcn_cvt_scalef32_pk_fp8_f32(r, a, b, inv_scale, false); r = __builtin_amdgcn_cvt_scalef32_pk_fp8_f32(r, c_, d, inv_scale, true);
    return __builtin_bit_cast(unsigned, r); }
__device__ __forceinline__ void cv_finish(const CvItem& c, const CvRegs& R) {
    v4u* d = (v4u*)(c.dst + c.doff); const float inv = 1.0f / c.scale;
#pragma unroll
    for (int q = 0; q < 2; ++q) { unsigned w[4];
#pragma unroll
        for (int u = 0; u < 4; ++u) { const int i = 16 * q + 4 * u;
#if CV_SCALED_CVT
            w[u] = pk4_fp8_scaled(R.v[i], R.v[i + 1], R.v[i + 2], R.v[i + 3], inv);
#else
            w[u] = pk4_fp8(R.v[i] * c.scale, R.v[i + 1] * c.scale, R.v[i + 2] * c.scale, R.v[i + 3] * c.scale);
#endif
        }
        d[q] = (v4u){w[0], w[1], w[2], w[3]}; }
}
constexpr int VP = 66;
template <int N> __device__ __forceinline__ float dpp_shr(float v) { return __builtin_bit_cast(float, __builtin_amdgcn_update_dpp(0, __builtin_bit_cast(int, v), 0x110 + N, 0xF, 0xF, true)); }
__device__ __forceinline__ float row_prefix16(float x) { x += dpp_shr<1>(x); x += dpp_shr<2>(x); x += dpp_shr<4>(x); x += dpp_shr<8>(x); return x; }
__device__ __forceinline__ float rowpair_sum(float x) {
    const int xi = __builtin_bit_cast(int, x); const auto r = __builtin_amdgcn_permlane16_swap(xi, xi, false, false); const int r0 = r[0], r1 = r[1];
    return __builtin_bit_cast(float, r0) + __builtin_bit_cast(float, r1); }
__device__ __forceinline__ float row_total16(float x) { x += dppmov<0xB1>(x); x += dppmov<0x4E>(x); x += dppmov<0x124>(x); x += dppmov<0x128>(x); return x; }
#ifndef PROBE_SCAN
#define PROBE_SCAN 0
#endif
#ifndef SCAN_B2B_IN_J2
#define SCAN_B2B_IN_J2 0
#endif
#ifndef SJ_W13
#define SJ_W13 1
#endif
#ifndef SJ_ISSUE_IN_J1
#define SJ_ISSUE_IN_J1 0
#endif
#ifndef SOLVER_GROUPED
#define SOLVER_GROUPED 1
#endif
__device__ __forceinline__ void scan_unit(Frame& F, int unit) {
    const int b = unit >> 4, h = (unit >> 1) & 7, dir = unit & 1;
    LAS float* ZS = (LAS float*)F.lds;
    LAS float* TWLA = ZS + 16 * 192;
    LAS float* VV = TWLA + 2 * 16 * 64;
    LAS float* YB = VV + 6 * 16 * VP;
    LAS float* PRM = YB + 16 * 64;
    LAS float* GL2 = PRM + 5 * 64;
    LAS float* MF2 = GL2 + 2 * 64;
    LAS float* RHS = MF2 + 2 * 256;
    LAS bf16* AL = (LAS bf16*)(RHS + 16 * 68);
    LAS bf16* W2T = AL + 16 * SC_ALD;
    LAS bf16* A2T = W2T + 64 * SC_WLD;
    LAS bf16* A12 = A2T + 64 * SC_WLD;
    LAS bf16* B1 = A12 + 2 * 32 * 72;
    LAS bf16* KCT2 = B1 + 32 * 72;
    LAS bf16* EV2 = KCT2 + 2 * 64 * 40;
    LAS bf16* MKI = EV2 + 2 * 64 * 40;
    LAS bf16* AY2 = MKI + 16 * 40;
    LAS bf16* SB = AY2 + 2 * 16 * 40;
    const bf16* Z = WSP(bf16, WS_Z);
    bf16* Y = (bf16*)F.out; float* CB = WSP(float, WS_CB);
    const int tid = F.tid, lane = F.lane, wv = F.wave, fr = lane & 15, fq = lane >> 4;
    __syncthreads();
    for (int i = tid; i < 32 * 64; i += NTHR) { const int j = i >> 6, c = i & 63;
        W2T[c * SC_WLD + j] = (bf16)f2bf(F.in[I_W2][(size_t)(dir * 32 + j) * 512 + h * 64 + c]); A2T[c * SC_WLD + j] = (bf16)f2bf(F.in[I_A2][(size_t)(dir * 32 + j) * 512 + h * 64 + c]); }
    if (tid < 64) { PRM[tid] = F.in[I_W0][dir * 512 + h * 64 + tid]; PRM[64 + tid] = F.in[I_A0][dir * 512 + h * 64 + tid];
        PRM[128 + tid] = F.in[I_KK][h * 64 + tid]; PRM[192 + tid] = F.in[I_KA][h * 64 + tid]; PRM[256 + tid] = F.in[I_RK][h * 64 + tid]; }
    for (int i = tid; i < 64 * 72; i += NTHR) SB[i] = 0;
    for (int i = tid; i < 2 * 64 * 40; i += NTHR) EV2[i] = 0;
    for (int i = tid; i < 16 * 40; i += NTHR) MKI[i] = 0;
    int ia, cg;
    if (wv < 6) { const int id = wv * 64 + lane; ia = id / 24; cg = id - 24 * ia; } else { ia = lane >> 2; cg = (wv == 6 ? 24 : 28) + (lane & 3); }
    int zcol;
    if (cg < 8) zcol = C_R + 64 * h + 8 * cg; else if (cg < 16) zcol = C_K + 64 * h + 8 * (cg - 8); else if (cg < 24) zcol = C_V + 64 * h + 8 * (cg - 16);
    else if (cg < 28) zcol = (dir ? C_WDB : C_WDF) + 8 * (cg - 24); else zcol = (dir ? C_ADB : C_ADF) + 8 * (cg - 28);
    float mu8[8];
#pragma unroll
    for (int e = 0; e < 8; ++e) mu8[e] = F.in[I_MU][zcol - (cg < 8 ? 0 : MU_SHIFT) + e];
    f32x4 Sacc[2] = {{0.f, 0.f, 0.f, 0.f}, {0.f, 0.f, 0.f, 0.f}};
    v4u pc, pn[4];
#define SCAN_GEOM(n_) const int k_ = (n_); const bool lat_ = k_ >= 16; const int li_ = dir ? 127 - (k_ - 16) : k_ - 16, ci_ = dir ? 15 - k_ : k_; \
        const int row0_ = lat_ ? zrow_lat(b, 16 * li_) : zrow_ctx(b, 16 * ci_), spos_ = lat_ ? 16 * (li_ & 3) : 16 * ci_, last_ = lat_ ? 63 : TC - 1; \
        const bool up_ = lat_ && (li_ >> 2) > 0, dn_ = lat_ && (li_ >> 2) < 31; const bool lf_ = spos_ + ia > 0, rt_ = spos_ + ia < last_
#define SCAN_ISSUE(n_) do { SCAN_GEOM(n_); const bf16* pz_ = Z + (size_t)(row0_ + ia) * INW + zcol; pc = *(const v4u*)pz_; \
        pn[0] = *(const v4u*)(pz_ - (lf_ ? INW : 0)); pn[1] = *(const v4u*)(pz_ + (rt_ ? INW : 0)); pn[2] = *(const v4u*)(pz_ - (up_ ? 64 * INW : 0)); pn[3] = *(const v4u*)(pz_ + (dn_ ? 64 * INW : 0)); } while (0)
#define ST_A(n_) do { float zs[8]; { SCAN_GEOM(n_); Nbr nb_; nb_.m[0] = lf_ ? 1.f : 0.f; nb_.m[1] = rt_ ? 1.f : 0.f; nb_.m[2] = up_ ? 1.f : 0.f; nb_.m[3] = dn_ ? 1.f : 0.f; nb_.coef = lat_ ? 0.25f : 0.5f; \
          shift8(pc, pn, nb_, mu8, zs); } \
        if (wv < 6) { *(LAS f32x4*)(ZS + ia * 192 + cg * 8) = (f32x4){zs[0], zs[1], zs[2], zs[3]}; *(LAS f32x4*)(ZS + ia * 192 + cg * 8 + 4) = (f32x4){zs[4], zs[5], zs[6], zs[7]}; } \
        else { if (wv == 6) { _Pragma("unroll") for (int e = 0; e < 8; ++e) zs[e] = 1.0f - 2.0f * __builtin_amdgcn_rcpf(1.0f + __builtin_amdgcn_exp2f(zs[e] * 2.88539008177793f)); } \
            *(LAS v4u*)(AL + ia * SC_ALD + (cg - 24) * 8) = (v4u){pk2(zs[0], zs[1]), pk2(zs[2], zs[3]), pk2(zs[4], zs[5]), pk2(zs[6], zs[7])}; } } while (0)
#define ST_B1_TILE(which_, nt_) do { const int which = (which_), nt = (nt_); \
        const bf16x8 af = *(const LAS bf16x8*)(AL + fr * SC_ALD + 32 * which + 8 * fq); \
        const bf16x8 bfr = *(const LAS bf16x8*)((which ? A2T : W2T) + (16 * nt + fr) * SC_WLD + 8 * fq); \
        const f32x4 acc = __builtin_amdgcn_mfma_f32_16x16x32_bf16(af, bfr, (f32x4){0.f, 0.f, 0.f, 0.f}, 0, 0, 0); \
        _Pragma("unroll") for (int r = 0; r < 4; ++r) TWLA[(which * 16 + 4 * fq + r) * 64 + 16 * nt + fr] = acc[r]; } while (0)
#define ST_B1() do { if (wv != 0) { ST_B1_TILE(wv >> 2, wv & 3); if (wv == 1) ST_B1_TILE(0, 0); } } while (0)
#define ST_B2A(m_) do { const int ib = tid >> 5, c2 = (tid & 31) * 2, sp = dir ? 15 - ib : ib; \
        const f32x2 tw = *(const LAS f32x2*)(TWLA + ib * 64 + c2), la = *(const LAS f32x2*)(TWLA + (16 + ib) * 64 + c2); \
        const f32x2 zr = *(const LAS f32x2*)(ZS + ib * 192 + c2), zk = *(const LAS f32x2*)(ZS + ib * 192 + 64 + c2), zv = *(const LAS f32x2*)(ZS + ib * 192 + 128 + c2); \
        const f32x2 w0 = *(const LAS f32x2*)(PRM + c2), a0 = *(const LAS f32x2*)(PRM + 64 + c2), pkk = *(const LAS f32x2*)(PRM + 128 + c2), pka = *(const LAS f32x2*)(PRM + 192 + c2), prk = *(const LAS f32x2*)(PRM + 256 + c2); \
        float dd[2], aa[2], kh[2], kkr[2]; float ss = 0.f, cbp = 0.f; \
        _Pragma("unroll") for (int q = 0; q < 2; ++q) { \
            dd[q] = 0.60653065971263342f * fsigmoid(w0[q] + tw[q]); aa[q] = fsigmoid(a0[q] + la[q]); \
            kh[q] = zk[q] * (1.0f + (aa[q] - 1.0f) * pka[q]); kkr[q] = zk[q] * pkk[q]; \
            ss += kkr[q] * kkr[q]; cbp += zr[q] * kh[q] * prk[q]; } \
        ss = red16(ss); cbp = red16(cbp); ss = rowpair_sum(ss); cbp = rowpair_sum(cbp); \
        const float rn = __builtin_amdgcn_rsqf(ss + 1e-12f); \
        *(LAS f32x2*)(VV + (0 * 16 + sp) * VP + c2) = (f32x2){dd[0], dd[1]}; \
        *(LAS f32x2*)(VV + (1 * 16 + sp) * VP + c2) = (f32x2){kkr[0] * rn, kkr[1] * rn}; \
        *(LAS f32x2*)(VV + (2 * 16 + sp) * VP + c2) = (f32x2){kkr[0] * rn * aa[0], kkr[1] * rn * aa[1]}; \
        *(LAS f32x2*)(VV + (3 * 16 + sp) * VP + c2) = (f32x2){kh[0], kh[1]}; \
        *(LAS f32x2*)(VV + (4 * 16 + sp) * VP + c2) = zr; \
        *(LAS f32x2*)(VV + (5 * 16 + sp) * VP + c2) = zv; \
        if ((m_) >= 16 && (m_) < 144 && (tid & 31) == 0) CB[((size_t)dir * M_LAT + scan_base_row(m_, dir, b) + ib) * 8 + h] = cbp; } while (0)
#define ST_B2B(par_) do { const int sp = tid & 15, c2 = (tid >> 4) * 2; LAS bf16* A1p = A12 + (par_) * 32 * 72; LAS bf16* KCTp = KCT2 + (par_) * 64 * 40; LAS bf16* EVp = EV2 + (par_) * 64 * 40; \
        const f32x2 dd = *(const LAS f32x2*)(VV + (0 * 16 + sp) * VP + c2), kkn = *(const LAS f32x2*)(VV + (1 * 16 + sp) * VP + c2), kka = *(const LAS f32x2*)(VV + (2 * 16 + sp) * VP + c2), \
                    khv = *(const LAS f32x2*)(VV + (3 * 16 + sp) * VP + c2), rv = *(const LAS f32x2*)(VV + (4 * 16 + sp) * VP + c2), vv = *(const LAS f32x2*)(VV + (5 * 16 + sp) * VP + c2); \
        float okk[2], orr[2], oka[2], okh[2], ohc[2], oac[2]; \
        _Pragma("unroll") for (int q = 0; q < 2; ++q) { const float cum = row_prefix16(dd[q]); \
            const float g = fexp(-cum), gi = __builtin_amdgcn_rcpf(g), g15 = dppmov<0x15F>(g), glg = g15 * gi;     \
            const float gm1 = __builtin_bit_cast(float, __builtin_amdgcn_update_dpp(0x3f800000, __builtin_bit_cast(int, g), 0x111, 0xF, 0xF, false)); \
            okk[q] = kkn[q] * gm1; orr[q] = rv[q] * g; oka[q] = kka[q] * gi; okh[q] = khv[q] * gi; ohc[q] = khv[q] * glg; oac[q] = -(kka[q] * glg); \
            if (sp == 15) GL2[(par_) * 64 + c2 + q] = g; } \
        *(LAS unsigned*)(A1p + sp * 72 + c2) = pk2(okk[0], okk[1]); *(LAS unsigned*)(A1p + (16 + sp) * 72 + c2) = pk2(orr[0], orr[1]); \
        *(LAS unsigned*)(B1 + sp * 72 + c2) = pk2(oka[0], oka[1]); *(LAS unsigned*)(B1 + (16 + sp) * 72 + c2) = pk2(okh[0], okh[1]); \
        KCTp[c2 * 40 + sp] = (bf16)f2bf(ohc[0]); KCTp[(c2 + 1) * 40 + sp] = (bf16)f2bf(ohc[1]); \
        KCTp[c2 * 40 + 16 + sp] = (bf16)f2bf(oac[0]); KCTp[(c2 + 1) * 40 + 16 + sp] = (bf16)f2bf(oac[1]); \
        EVp[c2 * 40 + sp] = (bf16)f2bf(vv[0]); EVp[(c2 + 1) * 40 + sp] = (bf16)f2bf(vv[1]); } while (0)
#define ST_G(par_, gw0_) do { if (wv >= (gw0_) && wv < (gw0_) + 4) { const int rs = (wv - (gw0_)) >> 1, cj = (wv - (gw0_)) & 1; f32x4 acc = {0.f, 0.f, 0.f, 0.f}; const LAS bf16* A1p = A12 + (par_) * 32 * 72; \
        _Pragma("unroll") for (int ks = 0; ks < 2; ++ks) acc = __builtin_amdgcn_mfma_f32_16x16x32_bf16(*(const LAS bf16x8*)(A1p + (16 * rs + fr) * 72 + 32 * ks + 8 * fq), *(const LAS bf16x8*)(B1 + (16 * cj + fr) * 72 + 32 * ks + 8 * fq), acc, 0, 0, 0); \
        const int jlim_ = fr - rs;                                     \
        if (rs == 0 && cj == 0) { _Pragma("unroll") for (int r = 0; r < 4; ++r) { const int srow = 4 * fq + r; MF2[(par_) * 256 + srow * 16 + fr] = (fr < srow) ? acc[r] : 0.f; } } \
        else { LAS bf16* gd_ = rs == 0 ? MKI + fr : AY2 + (par_) * 16 * 40 + (cj ? 0 : 16) + fr; const float sg_ = (rs == 1 && cj == 0) ? -1.0f : 1.0f; \
            _Pragma("unroll") for (int r = 0; r < 4; ++r) { const int srow = 4 * fq + r; gd_[srow * 40] = (bf16)f2bf((jlim_ < srow) ? acc[r] * sg_ : 0.f); } } } } while (0)
    CvRegs cvr; CvItem cvi; cvi.src = nullptr; cvi.dst = nullptr; cvi.N = 0; cvi.loff = 0; cvi.doff = 0; cvi.scale = 0.f; cvi.nb = 0; cvi.nblk = 0; cvi.step = 0; cvi.jump = 0;
    bool cv_pending = false;
    SCAN_ISSUE(0);
    ST_A(0); SCAN_ISSUE(1); __syncthreads();
    ST_B1(); __syncthreads();
    ST_B2A(0); __syncthreads();
    ST_B2B(0); ST_A(1); SCAN_ISSUE(2); __syncthreads();
    ST_G(0, 4); ST_B1(); __syncthreads();
    ST_B2A(1); __syncthreads();
    for (int n = 0; n < 144; ++n) {
        const bool is_lat = n >= 16; const int par = n & 1, qar = par ^ 1;
        LAS bf16* A1p = A12 + par * 32 * 72; LAS bf16* EVp = EV2 + par * 64 * 40; LAS bf16* KCTp = KCT2 + par * 64 * 40;
        if (n >= 17) { const int iy = tid >> 5, v2i = (tid & 31) * 2; const f32x2 yv = *(const LAS f32x2*)(YB + iy * 64 + v2i);
            *(unsigned*)(Y + ((size_t)dir * M_LAT + scan_base_row(n - 1, dir, b) + iy) * 512 + h * 64 + v2i) = pk2(yv.x, yv.y); }
#if PROBE_SCAN == 11
        __builtin_amdgcn_s_sleep(16);
#endif
        f32x4 acc1 = {0.f, 0.f, 0.f, 0.f};
        { const int vi = wv & 3, which = wv >> 2;
          if (which == 0 || is_lat) {
#pragma unroll
              for (int ks = 0; ks < 2; ++ks) acc1 = __builtin_amdgcn_mfma_f32_16x16x32_bf16(*(const LAS bf16x8*)(A1p + (16 * which + fr) * 72 + 32 * ks + 8 * fq), *(const LAS bf16x8*)(SB + (16 * vi + fr) * 72 + 32 * ks + 8 * fq), acc1, 0, 0, 0); }
          if (which == 0) { acc1 = __builtin_amdgcn_mfma_f32_16x16x32_bf16(*(const LAS bf16x8*)(MKI + fr * 40 + 8 * fq), *(const LAS bf16x8*)(EVp + (16 * vi + fr) * 40 + 8 * fq), acc1, 0, 0, 0);
#pragma unroll
              for (int r = 0; r < 4; ++r) RHS[(4 * fq + r) * 68 + 16 * vi + fr] = acc1[r]; } }
        ST_A(n + 2 < 144 ? n + 2 : 143);
#if SIDEJOB == 1 && SJ_ISSUE_IN_J1
        if (wv != 0) { const int ph = n - (wv % 3);
            if (ph >= 0) { const int q = ph / 3, pm = ph - 3 * q, li = (wv - 1) + 7 * q;
                if (pm == 0 && li < 264) { cvi = cv_item(F, unit * 264 + li, lane); cv_issue(cvi, cvr); cv_pending = true; } } }
#endif
        SCAN_ISSUE(n + 3 < 144 ? n + 3 : 143);
#if !SCAN_B2B_IN_J2
        ST_B2B(qar);
#endif
        __syncthreads();
#if PROBE_SCAN == 5
        __syncthreads();
#endif
#if PROBE_SCAN == 12
        __builtin_amdgcn_s_sleep(16);
#endif
        { int lane_o_ = F.lane; asm volatile("" : "+v"(lane_o_));
          const int lane = lane_o_, fr = lane_o_ & 15, fq = lane_o_ >> 4;
        ST_B1();
#if SCAN_B2B_IN_J2
        ST_B2B(qar);
#else
        ST_G(qar, 4);
#endif
#if SJ_W13
        if (SIDEJOB == 1 && wv >= 1 && wv <= 3) {
            const int it = unit * 264 + (wv - 1) * 88 + n;
            if (cv_pending) { cv_finish(cvi, cvr); cv_pending = false; }
            if (n < 88) { if (n == 0) cvi = cv_item(F, it, lane); else cv_item_next(F, cvi, it, lane); cv_issue(cvi, cvr); cv_pending = true; } }
#else
        if (SIDEJOB == 1 && wv != 0) {
            const int ph = n - (wv % 3);
            if (ph >= 0) { const int q = ph / 3, pm = ph - 3 * q, li = (wv - 1) + 7 * q;
                if (!SJ_ISSUE_IN_J1 && pm == 0 && li < 264) { cvi = cv_item(F, unit * 264 + li, lane); cv_issue(cvi, cvr); cv_pending = true; }
                if (pm == 1 && cv_pending) { cv_finish(cvi, cvr); cv_pending = false; } } }
#endif
#if PROBE_SCAN == 1
        for (int rep_ = 0; rep_ < 2; ++rep_)
#endif
        if (wv == 0) { float e[16], rh[16]; const LAS float* MFp = MF2 + par * 256;
#if SOLVER_GROUPED
            f32x4 bk0[8], bk1[8];
#define SV_LD(bk_, o_, s_, nb_) do { _Pragma("unroll") for (int q_ = 0; q_ < (nb_); ++q_) bk_[(o_) + q_] = *(const LAS f32x4*)(MFp + (s_) * 16 + 4 * q_); } while (0)
#define SV_ROW(bk_, o_, s_) do { float a_ = rh[s_]; _Pragma("unroll") for (int j_ = 0; j_ < (s_); ++j_) a_ = __builtin_fmaf(-bk_[(o_) + (j_ >> 2)][j_ & 3], e[j_], a_); e[s_] = opq(a_); } while (0)
            SV_LD(bk0, 0, 1, 1); SV_LD(bk0, 1, 2, 1); SV_LD(bk0, 2, 3, 1); SV_LD(bk0, 3, 4, 1); SV_LD(bk0, 4, 5, 2); SV_LD(bk0, 6, 6, 2);
#pragma unroll
            for (int s2 = 0; s2 < 16; ++s2) rh[s2] = RHS[s2 * 68 + lane];
            SV_LD(bk1, 0, 7, 2); SV_LD(bk1, 2, 8, 2); SV_LD(bk1, 4, 9, 3);
            __builtin_amdgcn_sched_barrier(0);
            e[0] = rh[0];
            SV_ROW(bk0, 0, 1); SV_ROW(bk0, 1, 2); SV_ROW(bk0, 2, 3); SV_ROW(bk0, 3, 4); SV_ROW(bk0, 4, 5); SV_ROW(bk0, 6, 6);
            __builtin_amdgcn_sched_barrier(0);
            SV_LD(bk0, 0, 10, 3); SV_LD(bk0, 3, 11, 3);
            __builtin_amdgcn_sched_barrier(0);
            SV_ROW(bk1, 0, 7); SV_ROW(bk1, 2, 8); SV_ROW(bk1, 4, 9);
            __builtin_amdgcn_sched_barrier(0);
            SV_LD(bk1, 0, 12, 3); SV_LD(bk1, 3, 13, 4);
            __builtin_amdgcn_sched_barrier(0);
            SV_ROW(bk0, 0, 10); SV_ROW(bk0, 3, 11);
            __builtin_amdgcn_sched_barrier(0);
            SV_LD(bk0, 0, 14, 4); SV_LD(bk0, 4, 15, 4);
            __builtin_amdgcn_sched_barrier(0);
            SV_ROW(bk1, 0, 12); SV_ROW(bk1, 3, 13);
            __builtin_amdgcn_sched_barrier(0);
            SV_ROW(bk0, 0, 14); SV_ROW(bk0, 4, 15);
#undef SV_LD
#undef SV_ROW
#else
#pragma unroll
            for (int s2 = 0; s2 < 16; ++s2) rh[s2] = RHS[s2 * 68 + lane];
#pragma unroll
            for (int s2 = 0; s2 < 16; ++s2) { float a = rh[s2];
#pragma unroll
                for (int j4 = 0; j4 < (s2 + 3) / 4; ++j4) { const f32x4 m4 = *(const LAS f32x4*)(MFp + s2 * 16 + 4 * j4);
#pragma unroll
                    for (int q = 0; q < 4; ++q) if (4 * j4 + q < s2) a = __builtin_fmaf(-m4[q], e[4 * j4 + q], a); }
                e[s2] = opq(a); asm volatile("" ::: "memory"); }
#endif
            *(LAS v4u*)(EVp + lane * 40 + 16) = (v4u){pk2(e[0], e[1]), pk2(e[2], e[3]), pk2(e[4], e[5]), pk2(e[6], e[7])};
            *(LAS v4u*)(EVp + lane * 40 + 24) = (v4u){pk2(e[8], e[9]), pk2(e[10], e[11]), pk2(e[12], e[13]), pk2(e[14], e[15])}; }
        }
#if PROBE_SCAN == 6
        if (wv == 0) __builtin_amdgcn_s_sleep(8);
#endif
#if PROBE_SCAN == 7
        if (wv != 0) __builtin_amdgcn_s_sleep(8);
#endif
#if PROBE_SCAN == 8
        __builtin_amdgcn_s_sleep(8);
#endif
        __syncthreads();
#if PROBE_SCAN == 5
        __syncthreads();
#endif
        if (wv >= 4 && is_lat) { const int vi = wv & 3;
            acc1 = __builtin_amdgcn_mfma_f32_16x16x32_bf16(*(const LAS bf16x8*)(AY2 + par * 16 * 40 + fr * 40 + 8 * fq), *(const LAS bf16x8*)(EVp + (16 * vi + fr) * 40 + 8 * fq), acc1, 0, 0, 0);
#pragma unroll
            for (int r = 0; r < 4; ++r) { const int sp = 4 * fq + r, it = dir ? 15 - sp : sp; YB[it * 64 + 16 * vi + fr] = acc1[r]; } }
#pragma unroll
        for (int t = 0; t < 2; ++t) { const int tl = 2 * wv + t, vi = tl >> 2, ki = tl & 3;
            f32x4 acc = Sacc[t] * GL2[par * 64 + 16 * ki + fr];
            acc = __builtin_amdgcn_mfma_f32_16x16x32_bf16(*(const LAS bf16x8*)(EVp + (16 * vi + fr) * 40 + 8 * fq), *(const LAS bf16x8*)(KCTp + (16 * ki + fr) * 40 + 8 * fq), acc, 0, 0, 0);
            Sacc[t] = acc;
#pragma unroll
            for (int r = 0; r < 4; ++r) SB[(16 * vi + 4 * fq + r) * 72 + 16 * ki + fr] = (bf16)f2bf(acc[r]); }
#if PROBE_SCAN == 13
        __builtin_amdgcn_s_sleep(16);
#endif
        ST_B2A(n + 2);
#if SCAN_B2B_IN_J2
        ST_G(qar, 0);
#endif
        __syncthreads();
#if PROBE_SCAN == 5
        __syncthreads();
#endif
    }
    { const int iy = tid >> 5, v2i = (tid & 31) * 2; const f32x2 yv = *(const LAS f32x2*)(YB + iy * 64 + v2i);
      *(unsigned*)(Y + ((size_t)dir * M_LAT + scan_base_row(143, dir, b) + iy) * 512 + h * 64 + v2i) = pk2(yv.x, yv.y); }
    if (SIDEJOB == 1 && cv_pending) cv_finish(cvi, cvr);
#undef SCAN_ISSUE
#undef ST_A
#undef ST_B1
#undef ST_B1_TILE
#undef SCAN_GEOM
#undef ST_B2A
#undef ST_B2B
#undef ST_G
    __syncthreads();
}

constexpr int GLD = 72;
__device__ __forceinline__ bf16x8 lds_frag(const LAS bf16* img, int row, int k0) { return *(const LAS bf16x8*)(img + row * GLD + k0); }
__device__ __forceinline__ float flog(float x) { return __builtin_amdgcn_logf(x) * 0.69314718055994531f; }
constexpr int LAFLD = 68;
__device__ __forceinline__ void gla_unit(Frame& F, int unit) {
    const int b = unit >> 4, g = (unit >> 2) & 3, dir = (unit >> 1) & 1, vh = unit & 1;
    LAS bf16* QI = (LAS bf16*)F.lds; LAS bf16* KI = QI + 64 * GLD; LAS bf16* KOT = KI + 64 * GLD; LAS bf16* VT = KOT + 64 * GLD; LAS bf16* SC = VT + 64 * GLD; LAS bf16* ST = SC + 64 * GLD;
    LAS bf16* RQ = ST + 64 * GLD; LAS bf16* RK = RQ + 64 * GLD; LAS bf16* RV = RK + 64 * GLD;
    LAS bf16* OT = RV + 64 * GLD;
    LAS bf16* GADB = OT + 64 * GLD;
    LAS bf16* A2T = GADB + 64 * 40;
    LAS float* LAF = (LAS float*)(A2T + 64 * 40);
    LAS float* BL = LAF + 64 * LAFLD;
    LAS float* PART = BL + 64;
    const bf16* Z = WSP(bf16, WS_Z); bf16* O = WSP(bf16, WS_O);
    const int tid = F.tid, lane = F.lane, wv = F.wave, c = tid & 63, pg = wv;
    const int fr = lane & 15, fq = lane >> 4;
    const int pl = tid >> 3, g8 = tid & 7;
    const float ab = F.in[I_GLAB][dir * 256 + 64 * g + c];
    const int cgad = dir ? C_GADB : C_GADF;
    __syncthreads();
    for (int i = tid; i < 64 * GLD; i += NTHR) ST[i] = 0;
    for (int i = tid; i < 64 * 40; i += NTHR) { GADB[i] = 0; const int cc = i / 40, j = i % 40; A2T[i] = j < 16 ? (bf16)f2bf(F.in[I_GLA2][(size_t)(dir * 16 + j) * 256 + 64 * g + cc]) : (bf16)0; }
    f32x4 Sacc[2] = {{0.f, 0.f, 0.f, 0.f}, {0.f, 0.f, 0.f, 0.f}};
    const int tl0 = 2 * wv;
    v4u rq, rk, rv, rg;
#define GLA_BASE(n_) ((n_) < 4 ? zrow_ctx(b, 64 * (dir ? 3 - (n_) : (n_))) : zrow_lat(b, 64 * (dir ? 31 - ((n_) - 4) : ((n_) - 4))))
#define GLA_ISSUE(n_) do { const bf16* zr_ = Z + (size_t)(GLA_BASE(n_) + (dir ? 63 - pl : pl)) * INW; \
        rq = *(const v4u*)(zr_ + C_Q + 64 * g + 8 * g8); rk = *(const v4u*)(zr_ + C_KG + 64 * g + 8 * g8); rv = *(const v4u*)(zr_ + C_VG + 128 * g + 64 * vh + 8 * g8); \
        rg = *(const v4u*)(zr_ + cgad + 8 * (g8 & 1)); } while (0)
    GLA_ISSUE(0);
    __syncthreads();
    for (int n = 0; n < 36; ++n) {
        const bool is_lat = n >= 4; const int base = GLA_BASE(n);
        *(LAS v4u*)(RQ + pl * GLD + 8 * g8) = rq; *(LAS v4u*)(RK + pl * GLD + 8 * g8) = rk; *(LAS v4u*)(RV + pl * GLD + 8 * g8) = rv;
        if (g8 < 2) *(LAS v4u*)(GADB + pl * 40 + 8 * g8) = rg;
        GLA_ISSUE(n + 1 < 36 ? n + 1 : 35);
        __syncthreads();
#pragma unroll
        for (int t = 0; t < 2; ++t) { const int tl = tl0 + t, pi = tl >> 2, ci = tl & 3;
            const f32x4 acc = __builtin_amdgcn_mfma_f32_16x16x32_bf16(*(const LAS bf16x8*)(GADB + (16 * pi + fr) * 40 + 8 * fq), *(const LAS bf16x8*)(A2T + (16 * ci + fr) * 40 + 8 * fq), (f32x4){0.f, 0.f, 0.f, 0.f}, 0, 0, 0);
#pragma unroll
            for (int r = 0; r < 4; ++r) LAF[(16 * pi + 4 * fq + r) * LAFLD + 16 * ci + fr] = acc[r]; }
        { unsigned vtw[4];
#pragma unroll
          for (int e = 0; e < 4; ++e) vtw[e] = (unsigned)RV[(8 * pg + 2 * e) * GLD + c] | ((unsigned)RV[(8 * pg + 2 * e + 1) * GLD + c] << 16);
          *(LAS v4u*)(VT + c * GLD + 8 * pg) = (v4u){vtw[0], vtw[1], vtw[2], vtw[3]}; }
        __syncthreads();
        float cs[8]; float run = 0.f;
#pragma unroll
        for (int e = 0; e < 8; ++e) { const float sg = LAF[(8 * pg + e) * LAFLD + c] + ab;
            run -= flog(1.0f + fexp(-sg)) * (1.0f / 16.0f); cs[e] = run; }
        PART[pg * 64 + c] = run;
        __syncthreads();
        float pre = 0.f, tot = 0.f;
#pragma unroll
        for (int w = 0; w < 8; ++w) { const float pv = PART[w * 64 + c]; tot += pv; if (w < pg) pre += pv; }
        const float etot = fexp(tot);
        unsigned kow[4];
#pragma unroll
        for (int e = 0; e < 8; e += 2) {
            float ko[2];
#pragma unroll
            for (int u = 0; u < 2; ++u) { const float qv = bf1(RQ[(8 * pg + e + u) * GLD + c]), kv = bf1(RK[(8 * pg + e + u) * GLD + c]);
                const float eb = fexp(pre + cs[e + u]), ieb = __builtin_amdgcn_rcpf(eb); const float qi = qv * 0.125f * eb, ki = kv * ieb; ko[u] = ki * etot;
                QI[(8 * pg + e + u) * GLD + c] = (bf16)f2bf(qi); KI[(8 * pg + e + u) * GLD + c] = (bf16)f2bf(ki); }
            kow[e >> 1] = pk2(ko[0], ko[1]); }
        *(LAS v4u*)(KOT + c * GLD + 8 * pg) = (v4u){kow[0], kow[1], kow[2], kow[3]};
        if (pg == 0) BL[c] = etot;
        __syncthreads();
        if (is_lat) {
#pragma unroll
            for (int t = 0; t < 2; ++t) { const int tl = tl0 + t, mi = tl >> 2, ni = tl & 3; f32x4 acc = {0.f, 0.f, 0.f, 0.f};
                if (ni <= mi) {
#pragma unroll
                    for (int ks = 0; ks < 2; ++ks) acc = __builtin_amdgcn_mfma_f32_16x16x32_bf16(lds_frag(QI, 16 * mi + fr, 32 * ks + 8 * fq), lds_frag(KI, 16 * ni + fr, 32 * ks + 8 * fq), acc, 0, 0, 0); }
#pragma unroll
                for (int r = 0; r < 4; ++r) { const int p = 16 * mi + 4 * fq + r, j = 16 * ni + fr; SC[p * GLD + j] = (bf16)f2bf(j <= p ? acc[r] : 0.f); } }
            __syncthreads();
#pragma unroll
            for (int t = 0; t < 2; ++t) { const int tl = tl0 + t, mi = tl >> 2, vi = tl & 3; f32x4 acc = {0.f, 0.f, 0.f, 0.f};
#pragma unroll
                for (int ks = 0; ks < 2; ++ks) { acc = __builtin_amdgcn_mfma_f32_16x16x32_bf16(lds_frag(SC, 16 * mi + fr, 32 * ks + 8 * fq), lds_frag(VT, 16 * vi + fr, 32 * ks + 8 * fq), acc, 0, 0, 0);
                    acc = __builtin_amdgcn_mfma_f32_16x16x32_bf16(lds_frag(QI, 16 * mi + fr, 32 * ks + 8 * fq), lds_frag(ST, 16 * vi + fr, 32 * ks + 8 * fq), acc, 0, 0, 0); }
#pragma unroll
                for (int r = 0; r < 4; ++r) OT[(16 * mi + 4 * fq + r) * GLD + 16 * vi + fr] = (bf16)f2bf(acc[r]); }
        }
        __syncthreads();
        if (is_lat) *(v4u*)(O + ((size_t)dir * M_LAT + base + (dir ? 63 - pl : pl)) * 512 + 128 * g + 64 * vh + 8 * g8) = *(const LAS v4u*)(OT + pl * GLD + 8 * g8);
#pragma unroll
        for (int t = 0; t < 2; ++t) { const int tl = tl0 + t, ci = tl >> 2, vi = tl & 3;
            f32x4 acc = Sacc[t];
            const f32x4 dk = *(const LAS f32x4*)(BL + 16 * ci + 4 * fq);
            acc = acc * dk;
#pragma unroll
            for (int ks = 0; ks < 2; ++ks) acc = __builtin_amdgcn_mfma_f32_16x16x32_bf16(lds_frag(KOT, 16 * ci + fr, 32 * ks + 8 * fq), lds_frag(VT, 16 * vi + fr, 32 * ks + 8 * fq), acc, 0, 0, 0);
            Sacc[t] = acc;
            *(LAS v2u*)(ST + (16 * vi + fr) * GLD + 16 * ci + 4 * fq) = (v2u){pk2(acc[0], acc[1]), pk2(acc[2], acc[3])}; }
        if (SIDEJOB == 2) { }
    }
#undef GLA_ISSUE
#undef GLA_BASE
    __syncthreads();
}

constexpr int ALD = 104;
constexpr int GOLD = 516;
__device__ __forceinline__ void mix_unit(Frame& F, int unit) {
    LAS float* GO = (LAS float*)F.lds;
    LAS bf16* AI = (LAS bf16*)(GO + 32 * GOLD);
    const bf16* Z = WSP(bf16, WS_Z); const bf16* Y = (const bf16*)F.out; const bf16* O = WSP(bf16, WS_O); const float* CB = WSP(float, WS_CB);
    const bf16* G2T = WSP(bf16, WS_G2T); bf16* MIX = WSP(bf16, WS_MIX);
    const int tid = F.tid, lane = F.lane, wv = F.wave, row00 = unit * 32, fr = lane & 15, fq = lane >> 4;
    __syncthreads();
    if (tid < 32 * 12) { const int i = tid / 12, cgp = tid % 12, row = row00 + i, col = C_GD + 8 * cgp; const Nbr nb = nbr_of(row);
        const v4u pc = *(const v4u*)(Z + (size_t)row * INW + col); v4u pn[4];
#pragma unroll
        for (int q = 0; q < 4; ++q) pn[q] = *(const v4u*)(Z + (size_t)nb.r[q] * INW + col);
        float mu8[8], zs[8];
#pragma unroll
        for (int e = 0; e < 8; ++e) mu8[e] = F.in[I_MU][col - MU_SHIFT + e];
        shift8(pc, pn, nb, mu8, zs);
#pragma unroll
        for (int e = 0; e < 8; ++e) zs[e] = fsigmoid(zs[e]);
        *(LAS v4u*)(AI + i * ALD + 8 * cgp) = (v4u){pk2(zs[0], zs[1]), pk2(zs[2], zs[3]), pk2(zs[4], zs[5]), pk2(zs[6], zs[7])}; }
    __syncthreads();
    {
        bf16x8 af[2][3];
#pragma unroll
        for (int m = 0; m < 2; ++m)
#pragma unroll
            for (int ks = 0; ks < 3; ++ks) af[m][ks] = *(const LAS bf16x8*)(AI + (16 * m + fr) * ALD + 32 * ks + 8 * fq);
#pragma unroll
        for (int nn = 0; nn < 4; ++nn) { const int colb = 64 * wv + 16 * nn;
            bf16x8 bfg[3];
#pragma unroll
            for (int ks = 0; ks < 3; ++ks) bfg[ks] = *(const bf16x8*)(G2T + (size_t)(colb + fr) * 96 + 32 * ks + 8 * fq);
#pragma unroll
            for (int m = 0; m < 2; ++m) { f32x4 acc = {0.f, 0.f, 0.f, 0.f};
#pragma unroll
                for (int ks = 0; ks < 3; ++ks) acc = __builtin_amdgcn_mfma_f32_16x16x32_bf16(af[m][ks], bfg[ks], acc, 0, 0, 0);
#pragma unroll
                for (int r = 0; r < 4; ++r) GO[(16 * m + 4 * fq + r) * GOLD + colb + fr] = acc[r]; } }
    }
    __syncthreads();
    { const int col = 8 * lane, hh = lane >> 3, vcol = C_V + col;
      float mu8[8], gnw[8], gnb[8], glw[8];
#pragma unroll
      for (int e = 0; e < 8; ++e) { mu8[e] = F.in[I_MU][vcol - MU_SHIFT + e]; gnw[e] = F.in[I_GNW][col + e]; gnb[e] = F.in[I_GNB][col + e]; glw[e] = F.in[I_GLNW][col + e]; }
      v4u ny[2], no[2]; v4u npc, npn[4], ngg; float ncb; Nbr nnb;
#define MIX_LOAD(ti_) do { const int row_ = row00 + 4 * wv + (ti_); nnb = nbr_of(row_); \
        ny[0] = *(const v4u*)(Y + (size_t)row_ * 512 + col); ny[1] = *(const v4u*)(Y + ((size_t)M_LAT + row_) * 512 + col); \
        no[0] = *(const v4u*)(O + (size_t)row_ * 512 + col); no[1] = *(const v4u*)(O + ((size_t)M_LAT + row_) * 512 + col); \
        ncb = CB[(size_t)row_ * 8 + hh] + CB[((size_t)M_LAT + row_) * 8 + hh]; \
        npc = *(const v4u*)(Z + (size_t)row_ * INW + vcol); _Pragma("unroll") for (int q_ = 0; q_ < 4; ++q_) npn[q_] = *(const v4u*)(Z + (size_t)nnb.r[q_] * INW + vcol); \
        ngg = *(const v4u*)(Z + (size_t)row_ * INW + C_GG + col); } while (0)
      MIX_LOAD(0);
#pragma unroll
      for (int ti = 0; ti < 4; ++ti) { const int i = 4 * wv + ti, row = row00 + i;
        float yf[8], yb_[8], of[8], ob_[8]; unpack8(ny[0], yf); unpack8(ny[1], yb_); unpack8(no[0], of); unpack8(no[1], ob_);
        const v4u pc = npc, gw4 = ngg; v4u pn[4]; const Nbr nb = nnb; const float cb = ncb;
#pragma unroll
        for (int q = 0; q < 4; ++q) pn[q] = npn[q];
        if (ti < 3) MIX_LOAD(ti + 1);
        { float y[8];
#pragma unroll
          for (int e = 0; e < 8; ++e) y[e] = yf[e] + yb_[e];
          float sm = 0.f;
#pragma unroll
          for (int e = 0; e < 8; ++e) sm += y[e];
          const float mean = red8(sm) * (1.0f / 64.0f); float s2 = 0.f;
#pragma unroll
          for (int e = 0; e < 8; ++e) { y[e] -= mean; s2 += y[e] * y[e]; }
          const float rstd = __builtin_amdgcn_rsqf(red8(s2) * (1.0f / 64.0f) + GN_EPS);
          float vs[8], o[8]; shift8(pc, pn, nb, mu8, vs);
          const f32x4 g0 = *(const LAS f32x4*)(GO + i * GOLD + col), g1 = *(const LAS f32x4*)(GO + i * GOLD + col + 4);
          const float go[8] = {g0.x, g0.y, g0.z, g0.w, g1.x, g1.y, g1.z, g1.w};
#pragma unroll
          for (int e = 0; e < 8; ++e) o[e] = (y[e] * rstd * gnw[e] + gnb[e] + cb * vs[e]) * go[e];
#if OUTPROJ_F8
          { float q_[8];
#pragma unroll
            for (int e = 0; e < 8; ++e) q_[e] = clamp448f(o[e] * MIX_SCALE);
            *(v2u*)((unsigned char*)MIX + (size_t)row * D + col) = (v2u){pk4_fp8(q_[0], q_[1], q_[2], q_[3]), pk4_fp8(q_[4], q_[5], q_[6], q_[7])}; } }
#else
          *(v4u*)(MIX + (size_t)row * D + col) = (v4u){pk2(o[0], o[1]), pk2(o[2], o[3]), pk2(o[4], o[5]), pk2(o[6], o[7])}; }
#endif
        { float o[8];
#pragma unroll
          for (int e = 0; e < 8; ++e) o[e] = of[e] + ob_[e];
          float s2 = 0.f;
#pragma unroll
          for (int e = 0; e < 8; ++e) s2 += o[e] * o[e];
          const float rs = __builtin_amdgcn_rsqf(red16(s2) * (1.0f / 128.0f) + GLA_EPS);
          float gg[8]; unpack8(gw4, gg);
#pragma unroll
          for (int e = 0; e < 8; ++e) o[e] = o[e] * rs * glw[e] * (gg[e] * fsigmoid(gg[e]));
#if OUTPROJ_F8
          { float q_[8];
#pragma unroll
            for (int e = 0; e < 8; ++e) q_[e] = clamp448f(o[e] * MIX_SCALE);
            *(v2u*)((unsigned char*)MIX + (size_t)row * D + 512 + col) = (v2u){pk4_fp8(q_[0], q_[1], q_[2], q_[3]), pk4_fp8(q_[4], q_[5], q_[6], q_[7])}; } }
#else
          *(v4u*)(MIX + (size_t)row * D + 512 + col) = (v4u){pk2(o[0], o[1]), pk2(o[2], o[3]), pk2(o[4], o[5]), pk2(o[6], o[7])}; }
#endif
      }
#undef MIX_LOAD
    }
}

#ifndef P7_TREDUCE
#define P7_TREDUCE 1
#endif
constexpr int RWLD = 1028;
__device__ __forceinline__ void p7_ln_router(Frame& F) {
    const int gw = F.bid * NWAVES + F.wave, NGW = F.G * NWAVES;
    const float* mod = WSP(float, WS_MOD); const bf16* PROJ = WSP(bf16, WS_PROJ); unsigned char* H2 = WSP(unsigned char, WS_H2); float* AFF = WSP(float, WS_AFF);
    LAS float* RWT = (LAS float*)F.lds;
    __syncthreads();
    for (int i = F.tid; i < D * NE; i += NTHR) RWT[(i & 15) * RWLD + (i >> 4)] = F.in[I_RTW][i];
    __syncthreads();
    f32x4 lgv[4], lbv[4];
#pragma unroll
    for (int j = 0; j < 4; ++j) { lgv[j] = ((const f32x4*)F.in[I_LN1G] + F.lane)[64 * j]; lbv[j] = ((const f32x4*)F.in[I_LN1B] + F.lane)[64 * j]; }
    f32x4 nx[4]; v2u np_[4];
    if (gw < M_LAT) { const f32x4* xr = (const f32x4*)(F.in[I_X] + (size_t)gw * D) + F.lane; const v2u* pr = (const v2u*)(PROJ + (size_t)gw * D) + F.lane;
#pragma unroll
        for (int j = 0; j < 4; ++j) { nx[j] = xr[64 * j]; np_[j] = pr[64 * j]; } }
    for (int m = gw; m < M_LAT; m += NGW) {
        const int b = m >> 11; const float* mrow = mod + (size_t)b * 6 * D;
        f32x4 g1v[4], shv[4], scv[4];
#pragma unroll
        for (int j = 0; j < 4; ++j) { g1v[j] = ((const f32x4*)(mrow + 2 * D) + F.lane)[64 * j]; shv[j] = ((const f32x4*)(mrow + 3 * D) + F.lane)[64 * j]; scv[j] = ((const f32x4*)(mrow + 4 * D) + F.lane)[64 * j]; }
        f32x4 v[4]; float s = 0.f;
#pragma unroll
        for (int j = 0; j < 4; ++j) { const f32x4 pj = {bflo(np_[j].x), bfhi(np_[j].x), bflo(np_[j].y), bfhi(np_[j].y)}; v[j] = nx[j] * DN_ALPHA + g1v[j] * pj; s += (v[j].x + v[j].y) + (v[j].z + v[j].w); }
        { const int mn = (m + NGW < M_LAT) ? m + NGW : m;
          const f32x4* xr = (const f32x4*)(F.in[I_X] + (size_t)mn * D) + F.lane; const v2u* pr = (const v2u*)(PROJ + (size_t)mn * D) + F.lane;
#pragma unroll
          for (int j = 0; j < 4; ++j) { nx[j] = xr[64 * j]; np_[j] = pr[64 * j]; } }
        float mean = wave_sum_dpp(s) * (1.f / D); float s2 = 0.f;
#pragma unroll
        for (int j = 0; j < 4; ++j) { v[j] = v[j] - mean; s2 += (v[j].x * v[j].x + v[j].y * v[j].y) + (v[j].z * v[j].z + v[j].w * v[j].w); }
        float rstd = __builtin_amdgcn_rsqf(wave_sum_dpp(s2) * (1.f / D) + LN_EPS);
        unsigned long long* x1 = (unsigned long long*)(WSP(bf16, WS_X1) + (size_t)m * D) + F.lane;
        s = 0.f;
#pragma unroll
        for (int j = 0; j < 4; ++j) { v[j] = v[j] * rstd * lgv[j] + lbv[j]; x1[64 * j] = (unsigned long long)pk2(v[j].x, v[j].y) | ((unsigned long long)pk2(v[j].z, v[j].w) << 32); s += (v[j].x + v[j].y) + (v[j].z + v[j].w); }
        mean = wave_sum_dpp(s) * (1.f / D); s2 = 0.f;
#pragma unroll
        for (int j = 0; j < 4; ++j) { v[j] = v[j] - mean; s2 += (v[j].x * v[j].x + v[j].y * v[j].y) + (v[j].z * v[j].z + v[j].w * v[j].w); }
        rstd = __builtin_amdgcn_rsqf(wave_sum_dpp(s2) * (1.f / D) + LN_EPS);
        unsigned* o4 = (unsigned*)(H2 + (size_t)m * D) + F.lane;
        float lg16[16];
#pragma unroll
        for (int j = 0; j < 4; ++j) { v[j] = v[j] * rstd * (scv[j] + 1.0f) + shv[j];
            o4[64 * j] = pk4_fp8(v[j].x * XIN_L, v[j].y * XIN_L, v[j].z * XIN_L, v[j].w * XIN_L); }
#pragma unroll
        for (int e = 0; e < 16; ++e) { float a = 0.f;
#pragma unroll
            for (int j = 0; j < 4; ++j) { const f32x4 w = *(const LAS f32x4*)(RWT + e * RWLD + 256 * j + 4 * F.lane);
                a = __builtin_fmaf(v[j].x, w.x, a); a = __builtin_fmaf(v[j].y, w.y, a); a = __builtin_fmaf(v[j].z, w.z, a); a = __builtin_fmaf(v[j].w, w.w, a); }
            lg16[e] = a;
            if ((e & 3) == 3) __builtin_amdgcn_sched_barrier(0); }
#if P7_TREDUCE
        float x8[8], y4[4], z2[2];
#pragma unroll
        for (int i = 0; i < 8; ++i) { const auto r = __builtin_amdgcn_permlane32_swap(__builtin_bit_cast(int, lg16[i]), __builtin_bit_cast(int, lg16[i + 8]), false, false);
            const int r0 = r[0], r1 = r[1]; x8[i] = __builtin_bit_cast(float, r0) + __builtin_bit_cast(float, r1); }
#pragma unroll
        for (int i = 0; i < 4; ++i) { const auto r = __builtin_amdgcn_permlane16_swap(__builtin_bit_cast(int, x8[i]), __builtin_bit_cast(int, x8[i + 4]), false, false);
            const int r0 = r[0], r1 = r[1]; y4[i] = __builtin_bit_cast(float, r0) + __builtin_bit_cast(float, r1); }
        const bool b3 = (F.lane & 8) != 0, b2 = (F.lane & 4) != 0;
#pragma unroll
        for (int i = 0; i < 2; ++i) { const float t = b3 ? y4[i + 2] : y4[i], u = b3 ? y4[i] : y4[i + 2]; z2[i] = t + dppmov<0x128>(u); }
        float mine; { const float t = b2 ? z2[1] : z2[0], u = b2 ? z2[0] : z2[1]; mine = t + dppmov<0x141>(u); }
        mine += dppmov<0xB1>(mine); mine += dppmov<0x4E>(mine);
        float mx = fmaxf(mine, dppmov<0x141>(mine)); mx = fmaxf(mx, dppmov<0x140>(mx));
        { const auto r = __builtin_amdgcn_permlane16_swap(__builtin_bit_cast(int, mx), __builtin_bit_cast(int, mx), false, false); const int r0 = r[0], r1 = r[1]; mx = fmaxf(__builtin_bit_cast(float, r0), __builtin_bit_cast(float, r1)); }
        { const auto r = __builtin_amdgcn_permlane32_swap(__builtin_bit_cast(int, mx), __builtin_bit_cast(int, mx), false, false); const int r0 = r[0], r1 = r[1]; mx = fmaxf(__builtin_bit_cast(float, r0), __builtin_bit_cast(float, r1)); }
        const float ex = fexp(mine - mx), den = wave_sum_dpp(ex) * 0.25f;
        if ((F.lane & 3) == 0) AFF[(size_t)m * NE + (F.lane >> 2)] = ex * __builtin_amdgcn_rcpf(den);
#else
        float mx = -1e30f;
#pragma unroll
        for (int e = 0; e < 16; ++e) { lg16[e] = wave_sum_dpp(lg16[e]); mx = fmaxf(mx, lg16[e]); }
        float mine = 0.f;
#pragma unroll
        for (int e = 0; e < 16; ++e) mine = (F.lane == e) ? lg16[e] : mine;
        const float ex = fexp(mine - mx), den = row_total16(ex);
        if (F.lane < 16) AFF[(size_t)m * NE + F.lane] = ex * __builtin_amdgcn_rcpf(den);
#endif
    }
    __syncthreads();
}

__device__ __forceinline__ void p8_topk_unit(Frame& F, int unit) {
    const int b = unit >> 4, e = unit & 15;
    LAS unsigned long long* KEY = (LAS unsigned long long*)F.lds;
    const float* AFF = WSP(float, WS_AFF); int* SELPOS = WSP(int, WS_SELPOS); float* GATE = WSP(float, WS_GATE);
    const unsigned char* H2 = WSP(unsigned char, WS_H2); unsigned char* XIN = WSP(unsigned char, WS_XIN);
    const int tid = F.tid;
    __syncthreads();
    for (int t = tid; t < T; t += NTHR) { const float a = AFF[((size_t)b * T + t) * NE + e];
        KEY[t] = ((unsigned long long)__builtin_bit_cast(unsigned, a) << 32) | (unsigned long long)(0xFFFFFFFFu - (unsigned)t); }
    __syncthreads();
    for (int k = 2; k <= T; k <<= 1)
        for (int j = k >> 1; j > 0; j >>= 1) {
#pragma unroll
            for (int q = 0; q < 2; ++q) { const int pi = tid + NTHR * q; const int i = ((pi & ~(j - 1)) << 1) | (pi & (j - 1)), l = i | j;
                const unsigned long long x = KEY[i], y = KEY[l]; const bool desc = (i & k) == 0;
                if (desc ? (x < y) : (x > y)) { KEY[i] = y; KEY[l] = x; } }
            __syncthreads();
        }
    for (int p = tid; p < T; p += NTHR) { const unsigned long long kv = KEY[p]; const int t = (int)(0xFFFFFFFFu - (unsigned)(kv & 0xFFFFFFFFull));
        SELPOS[((size_t)b * NE + e) * T + t] = p < CAP ? p : -1;
        if (p < CAP) GATE[((size_t)b * NE + e) * CAP + p] = __builtin_bit_cast(float, (unsigned)(kv >> 32)); }
    for (int p0 = F.wave * 8; p0 < CAP; p0 += NWAVES * 8) { v4u rowv[8];
#pragma unroll
        for (int u = 0; u < 8; ++u) { const unsigned long long kv = KEY[p0 + u]; const int t = (int)(0xFFFFFFFFu - (unsigned)(kv & 0xFFFFFFFFull));
            rowv[u] = *((const v4u*)(H2 + ((size_t)b * T + t) * D) + F.lane); }
#pragma unroll
        for (int u = 0; u < 8; ++u) *((v4u*)(XIN + ((size_t)e * (NB * CAP) + b * CAP + p0 + u) * D) + F.lane) = rowv[u]; }
    __syncthreads();
}

struct P11Slots { float g[4]; unsigned y[4][4]; };
__device__ __forceinline__ unsigned long long p11_mask(int pv) { return __builtin_amdgcn_ballot_w64(pv >= 0) & 0xffffull; }
__device__ __forceinline__ void p11_issue(Frame& F, int m, int pv, unsigned long long mask, P11Slots& S) {
    const float* GATE = WSP(float, WS_GATE); const unsigned char* YE = WSP(unsigned char, WS_YE); const int b = m >> 11;
#pragma unroll
    for (int i = 0; i < 4; ++i) { const bool on = mask != 0ull; const int e = on ? (int)__builtin_ctzll(mask) : 0; mask &= mask - 1ull;
        const int pos = on ? __builtin_amdgcn_readlane(pv, e) : 0;
        const float gt = GATE[((size_t)b * NE + e) * CAP + pos]; S.g[i] = on ? gt * (1.0f / YE_SCALE) : 0.f;
        const unsigned* yr = (const unsigned*)(YE + ((size_t)e * (NB * CAP) + b * CAP + pos) * D) + F.lane;
#pragma unroll
        for (int j = 0; j < 4; ++j) S.y[i][j] = yr[64 * j]; }
}
__device__ __forceinline__ void p11_final(Frame& F) {
    const int gw = F.bid * NWAVES + F.wave, NGW = F.G * NWAVES;
    const float* mod = WSP(float, WS_MOD); const int* SELPOS = WSP(int, WS_SELPOS); const float* GATE = WSP(float, WS_GATE); const unsigned char* YE = WSP(unsigned char, WS_YE); const bf16* X1 = WSP(bf16, WS_X1);
    const f32x4* lg = (const f32x4*)F.in[I_LN2G] + F.lane; const f32x4* lb = (const f32x4*)F.in[I_LN2B] + F.lane;
    const int le = F.lane & 15;
    auto p11_pos = [&](int m_) -> int { const int mm = m_ < M_LAT ? m_ : M_LAT - 1;
        const int val = SELPOS[((size_t)(mm >> 11) * NE + le) * T + (mm & (T - 1))]; return (F.lane < 16 && m_ < M_LAT) ? val : -1; };
#define P11_POS(m_) p11_pos(m_)
    f32x4 lgv[4], lbv[4];
#pragma unroll
    for (int j = 0; j < 4; ++j) { lgv[j] = lg[64 * j]; lbv[j] = lb[64 * j]; }
    v2u nx[4]; P11Slots ns; int pv_cur = -1, pv_next = -1;
    if (gw < M_LAT) { const v2u* xr = (const v2u*)(X1 + (size_t)gw * D) + F.lane;
#pragma unroll
        for (int j = 0; j < 4; ++j) nx[j] = xr[64 * j];
        pv_cur = P11_POS(gw); pv_next = P11_POS(gw + NGW);
        p11_issue(F, gw, pv_cur, p11_mask(pv_cur), ns); }
    for (int m = gw; m < M_LAT; m += NGW) {
        const int b = m >> 11; const float* mrow = mod + (size_t)b * 6 * D;
        f32x4 xv[4]; P11Slots cs; const int pv = pv_cur; unsigned long long mask = p11_mask(pv);
#pragma unroll
        for (int j = 0; j < 4; ++j) xv[j] = (f32x4){bflo(nx[j].x), bfhi(nx[j].x), bflo(nx[j].y), bfhi(nx[j].y)};
#pragma unroll
        for (int i = 0; i < 4; ++i) { cs.g[i] = ns.g[i];
#pragma unroll
            for (int j = 0; j < 4; ++j) cs.y[i][j] = ns.y[i][j]; }
        f32x4 g2v[4];
#pragma unroll
        for (int j = 0; j < 4; ++j) g2v[j] = ((const f32x4*)(mrow + 5 * D) + F.lane)[64 * j];
        { const bool more = m + NGW < M_LAT; const int m2 = more ? m + NGW : m; const v2u* xr = (const v2u*)(X1 + (size_t)m2 * D) + F.lane;
#pragma unroll
            for (int j = 0; j < 4; ++j) nx[j] = xr[64 * j];
            pv_cur = pv_next; p11_issue(F, m2, pv_cur, p11_mask(pv_cur), ns); pv_next = P11_POS(more ? m2 + NGW : M_LAT); }
        f32x4 acc[4];
#pragma unroll
        for (int j = 0; j < 4; ++j) acc[j] = (f32x4){0.f, 0.f, 0.f, 0.f};
#pragma unroll
        for (int i = 0; i < 4; ++i) {
#pragma unroll
            for (int j = 0; j < 4; ++j) { float f[4]; unpack4_fp8(cs.y[i][j], f); acc[j].x += cs.g[i] * f[0]; acc[j].y += cs.g[i] * f[1]; acc[j].z += cs.g[i] * f[2]; acc[j].w += cs.g[i] * f[3]; } }
        { unsigned long long rest = mask;
#pragma unroll
          for (int i = 0; i < 4; ++i) rest &= rest - 1ull;
          while (rest != 0ull) { const int e = (int)__builtin_ctzll(rest); rest &= rest - 1ull; const int pos = __builtin_amdgcn_readlane(pv, e);
              const float gt = GATE[((size_t)b * NE + e) * CAP + pos] * (1.0f / YE_SCALE);
              const unsigned* yr = (const unsigned*)(YE + ((size_t)e * (NB * CAP) + b * CAP + pos) * D) + F.lane;
#pragma unroll
              for (int j = 0; j < 4; ++j) { float f[4]; unpack4_fp8(yr[64 * j], f); acc[j].x += gt * f[0]; acc[j].y += gt * f[1]; acc[j].z += gt * f[2]; acc[j].w += gt * f[3]; } } }
        f32x4* x1 = (f32x4*)(F.out + (size_t)m * D) + F.lane;
        f32x4 v[4]; float s = 0.f;
#pragma unroll
        for (int j = 0; j < 4; ++j) { v[j] = xv[j] * DN_ALPHA + g2v[j] * acc[j]; s += (v[j].x + v[j].y) + (v[j].z + v[j].w); }
        const float mean = wave_sum_dpp(s) * (1.f / D); float s2 = 0.f;
#pragma unroll
        for (int j = 0; j < 4; ++j) { v[j] = v[j] - mean; s2 += (v[j].x * v[j].x + v[j].y * v[j].y) + (v[j].z * v[j].z + v[j].w * v[j].w); }
        const float rstd = __builtin_amdgcn_rsqf(wave_sum_dpp(s2) * (1.f / D) + LN_EPS);
#pragma unroll
        for (int j = 0; j < 4; ++j) x1[64 * j] = v[j] * rstd * lgv[j] + lbv[j];
    }
#undef P11_POS
}

constexpr int N_PHASES = 12;
__global__ void __launch_bounds__(NTHR, 2) fwd_kernel(Args args) {
    extern __shared__ __attribute__((aligned(16))) unsigned char lds[];
    Frame F;
    F.lds = (LAS unsigned char*)lds;
    F.tid = threadIdx.x; F.lane = F.tid & 63; F.wave = __builtin_amdgcn_readfirstlane(F.tid >> 6);
    F.G = gridDim.x; F.bid = blockIdx.x;
    F.in = args.in; F.out = args.out; F.ws = args.ws;
    volatile LAS unsigned* MISC = (volatile LAS unsigned*)(F.lds + MISC_OFF);
    for (int u = F.tid; u < (LDS_BYTES - LDSCTL_OFF) / 4; u += NTHR) ((LAS unsigned*)(F.lds + LDSCTL_OFF))[u] = 0u;
    __syncthreads();
    const int lo = args.ph_lo, hi = args.ph_hi;
    const bool multi = (hi - lo) > 1;
    XcdBarrier bar; bar.bar = (unsigned*)(F.ws + WS_CTL) + CW_BAR; bar.x = 0; bar.st = nullptr;
    if (multi) bar = xcd_barrier_post((unsigned*)(F.ws + WS_CTL) + CW_BAR, MISC + 8);
#ifndef PROBE_REP
#define PROBE_REP 0
#endif
#define IN(k) (lo <= (k) && (k) < hi)
#ifndef PROBE_REPN
#define PROBE_REPN 1
#endif
#define REP(k) for (int _r = 0; _r <= PROBE_REPN * ((PROBE_REP >> (k)) & 1); ++_r)
#define SEAM(k) do { if (IN(k) && IN((k) + 1)) xcd_barrier(bar); } while (0)
    using namespace pg8;
    if (IN(0)) REP(0) { p0_prologue(F); } SEAM(0);
    if (IN(1)) REP(1) { p1_ln_mod(F); } SEAM(1);
#ifdef PROBE_BARRIERS
    for (int pb_ = 0; pb_ < PROBE_BARRIERS; ++pb_) xcd_barrier(bar);
#endif
    if (IN(2)) REP(2) {
        Gemm g{WSP(bf16_t, WS_H0), WSP(bf16_t, WS_WIN), M_ALL, INW, D}; InProjOrder S; S.init(M_LAT, M_CTX, INW, 5, F.G, F.bid);
#if INPROJ_F8
        EpiBf16 E{WSP(bf16_t, WS_Z), INW, 1.0f / (HA_SCALE * WIN_SCALE)};
        gemm_phase<EpiBf16, InProjOrder, true>(F.lds, g, S, E);
#else
        EpiBf16 E{WSP(bf16_t, WS_Z), INW, 1.0f};
        gemm_phase<EpiBf16, InProjOrder>(F.lds, g, S, E);
#endif
    } SEAM(2);
    if (IN(3)) REP(3) { for (int u = F.bid; u < 256; u += F.G) scan_unit(F, u); }
    if (IN(4)) REP(4) { for (int u = F.bid; u < 256; u += F.G) gla_unit(F, u); } SEAM(4);
    if (IN(5)) REP(5) { for (int u = F.bid; u < M_LAT / 32; u += F.G) mix_unit(F, u); __syncthreads(); } SEAM(5);
    if (IN(6)) REP(6) {
        Gemm g{WSP(bf16_t, WS_MIX), WSP(bf16_t, WS_WOUT), M_LAT, D, D}; StaticOrder S; S.init(M_LAT, D, F.G, F.bid);
#if OUTPROJ_F8
        EpiBf16 E{WSP(bf16_t, WS_PROJ), D, 1.0f / (MIX_SCALE * WOUT_SCALE)};
        gemm_phase<EpiBf16, StaticOrder, true>(F.lds, g, S, E);
#else
        EpiBf16 E{WSP(bf16_t, WS_PROJ), D, 1.0f};
        gemm_phase<EpiBf16, StaticOrder>(F.lds, g, S, E);
#endif
    } SEAM(6);
    if (IN(7)) REP(7) { p7_ln_router(F); } SEAM(7);
    if (IN(8)) REP(8) { for (int u = F.bid; u < NB * NE; u += F.G) p8_topk_unit(F, u); } SEAM(8);
    if (IN(9)) REP(9) {
        Gemm g{WSP(bf16_t, WS_XIN), WSP(bf16_t, WS_WGU), NE * NB * CAP, 2 * FF, D}; StaticOrder S; S.init(NE * NB * CAP, 2 * FF, F.G, F.bid, 16, 0);
        EpiSwiGLU8 E{WSP(unsigned char, WS_HH), FF, 1.0f / W1_SCALE, H_SCALE};
        gemm_phase<EpiSwiGLU8, StaticOrder, true>(F.lds, g, S, E);
    } SEAM(9);
    if (IN(10)) REP(10) {
        Gemm g{WSP(bf16_t, WS_HH), WSP(bf16_t, WS_WD), NE * NB * CAP, D, FF}; StaticOrder S; S.init(NE * NB * CAP, D, F.G, F.bid, 16, 0);
        EpiF8 E{WSP(unsigned char, WS_YE), D, YE_SCALE / (H_SCALE * W2_SCALE)};
        gemm_phase<EpiF8, StaticOrder, true>(F.lds, g, S, E);
    } SEAM(10);
    if (IN(11)) REP(11) { p11_final(F); }
#undef IN
#undef SEAM
}

extern "C" void kernel_launch(void* const* d_in, const int* in_sizes, int n_in, void* d_out, int out_size, void* d_ws, size_t ws_size, hipStream_t stream) {
    static int grid = 0;
    if (grid == 0) {
        if (n_in != N_IN || out_size != M_LAT * D || ws_size < WS_END) { fprintf(stderr, "kernel_launch: unexpected shapes (n_in %d, out %d, ws %zu)\n", n_in, out_size, ws_size); grid = -1; return; }
        int dev = 0, cus = 0;
        if (hipGetDevice(&dev) != hipSuccess || hipDeviceGetAttribute(&cus, hipDeviceAttributeMultiprocessorCount, dev) != hipSuccess) { grid = -1; return; }
        if (hipFuncSetAttribute((const void*)fwd_kernel, hipFuncAttributeMaxDynamicSharedMemorySize, LDS_BYTES) != hipSuccess) { fprintf(stderr, "kernel_launch: hipFuncSetAttribute failed\n"); grid = -1; return; }
        (void)hipGetLastError();
        grid = cus;
    }
    if (grid < 0) return;
    (void)hipMemsetAsync((char*)d_ws + WS_CTL, 0, CTL_ZERO_BYTES, stream);
    Args a{};
    for (int i = 0; i < N_IN; ++i) a.in[i] = (const float*)d_in[i];
    a.out = (float*)d_out; a.ws = (unsigned char*)d_ws;
#ifndef MK_ONE_LAUNCH
#define MK_ONE_LAUNCH 1
#endif
    if (MK_ONE_LAUNCH) { a.ph_lo = 0; a.ph_hi = N_PHASES; hipLaunchKernelGGL(fwd_kernel, dim3(grid), dim3(NTHR), LDS_BYTES, stream, a); }
    else {
        const int cuts[] = {0, 1, 2, 3, 5, 6, 7, 8, 9, 10, 11, 12};
        for (int li = 0; li + 1 < (int)(sizeof(cuts) / sizeof(cuts[0])); ++li) { a.ph_lo = cuts[li]; a.ph_hi = cuts[li + 1]; hipLaunchKernelGGL(fwd_kernel, dim3(grid), dim3(NTHR), LDS_BYTES, stream, a); }
    }
}
```

```cpp
#include <hip/hip_runtime.h>
#include <cstdio>
#include <cstdint>

namespace pg8 {
#define PG8_LAS __attribute__((address_space(3)))
typedef unsigned short bf16_t;
typedef short bf16x8 __attribute__((ext_vector_type(8)));
typedef float f32x4 __attribute__((ext_vector_type(4)));
typedef unsigned u32x4 __attribute__((ext_vector_type(4)));
typedef unsigned u32x2 __attribute__((ext_vector_type(2)));
typedef int i32x4 __attribute__((ext_vector_type(4)));
typedef int i32x8 __attribute__((ext_vector_type(8)));
constexpr int BM = 256, BK = 64, HALF = 128, HTB = HALF * BK * 2  , STAGE_BYTES = 8 * HTB, NXCD = 8, WGM = 8;

__host__ __device__ __forceinline__ int lds_byte(int r, int c) { const int st = (r >> 4) * 2 + (c >> 5), rr = r & 15, cc = c & 31, ob = rr * 64 + cc * 2; return st * 1024 + (ob ^ (((ob >> 9) & 1) << 5)); }
__host__ __device__ __forceinline__ void stage_rc(int b, int& R, int& C) { const int st = b / 1024, sb = b % 1024, swz = sb ^ (((sb >> 9) & 1) << 5); R = (st >> 1) * 16 + swz / 64; C = (st & 1) * 32 + (swz % 64) / 2; }
__host__ __device__ __forceinline__ int perm32(int rho) { const int n = rho >> 4, i = rho & 15; return 8 * (i >> 2) + 4 * n + (i & 3); }

struct Unit { int pm, pn, pb; };
struct Gemm { const bf16_t* A; const bf16_t* Bt; int M, N, K; };

struct StaticOrder {
    int nM, nN, nwg, G, c, grp, bbase;
    __host__ __device__ void init(int M, int N, int G_, int c_, int grp_ = 0, int bbase_ = 0) { nM = M / BM; nN = N / BM; nwg = nM * nN; G = G_; c = c_; grp = grp_; bbase = bbase_; }
    __host__ __device__ bool next(int i, Unit& u) const {
        const long L = (long)i * G + c; if (L >= nwg) return false;
        int wgid = (int)L; { const int q = nwg / NXCD, r = nwg % NXCD, xcd = wgid % NXCD, off = wgid / NXCD; wgid = (xcd < r ? xcd * (q + 1) : r * (q + 1) + (xcd - r) * q) + off; }
        const int nig = WGM * nN, gid = wgid / nig, fm = gid * WGM, gsz = (nM - fm) < WGM ? (nM - fm) : WGM;
        u.pm = fm + ((wgid % nig) % gsz); u.pn = (wgid % nig) / gsz; u.pb = bbase + (grp ? (u.pm / grp) * nN : 0) + u.pn; return true;
    }
};

struct InProjOrder {
    StaticOrder lat; int nlat, nctx_n, first_ctx_pm, skip_n, ntot, G, c;
    __host__ __device__ void init(int lat_rows, int ctx_rows, int N, int skip_n_, int G_, int c_) { lat.init(lat_rows, N, G_, c_); nlat = lat.nwg; skip_n = skip_n_; nctx_n = N / BM - skip_n_; first_ctx_pm = lat_rows / BM; ntot = nlat + (ctx_rows / BM) * nctx_n; G = G_; c = c_; }
    __host__ __device__ bool next(int i, Unit& u) const {
        const long L = (long)i * G + c; if (L >= ntot) return false;
        if (L < nlat) { StaticOrder t = lat; t.G = G; t.c = c; return t.next(i, u); }
        const int j = (int)L - nlat; u.pm = first_ctx_pm + j / nctx_n; u.pn = skip_n + j % nctx_n; u.pb = u.pn; return true;
    }
};

__device__ __forceinline__ unsigned cvt_pk_bf16(float lo, float hi) { unsigned r; asm volatile("v_cvt_pk_bf16_f32 %0, %1, %2" : "=v"(r) : "v"(lo), "v"(hi)); return r; }

struct EpiF32 {
    static constexpr bool PERM = false; static constexpr int WSCALE = 0x7f7f7f7f;
    float* C; int ldc;
    __device__ __forceinline__ void operator()(const f32x4 (&acc)[2][2][4][2], const Unit& u, int wr, int wc, int fr, int fq) const {
        const int row0 = u.pm * BM + wr * 64 + fr, col0 = u.pn * BM + wc * 32 + 4 * fq;
#pragma unroll
        for (int ai = 0; ai < 2; ++ai)
#pragma unroll
            for (int m = 0; m < 4; ++m) { float* rowp = C + (size_t)(row0 + ai * HALF + m * 16) * ldc + col0;
#pragma unroll
                for (int bj = 0; bj < 2; ++bj)
#pragma unroll
                    for (int n = 0; n < 2; ++n) *(f32x4*)(rowp + bj * HALF + n * 16) = acc[ai][bj][m][n]; }
    }
};
struct EpiBf16 {
    static constexpr bool PERM = true; static constexpr int WSCALE = 0x7f7f7f7f;
    bf16_t* O; int ldc; float scale;
    __device__ __forceinline__ void operator()(const f32x4 (&acc)[2][2][4][2], const Unit& u, int wr, int wc, int fr, int fq) const {
        const int row0 = u.pm * BM + wr * 64 + fr, col0 = u.pn * BM + wc * 32 + 8 * fq;
#pragma unroll
        for (int ai = 0; ai < 2; ++ai)
#pragma unroll
            for (int m = 0; m < 4; ++m) { bf16_t* rowp = O + (size_t)(row0 + ai * HALF + m * 16) * ldc + col0;
#pragma unroll
                for (int bj = 0; bj < 2; ++bj) { const f32x4 v0 = acc[ai][bj][m][0] * scale, v1 = acc[ai][bj][m][1] * scale;
                    u32x4 w; w.x = cvt_pk_bf16(v0[0], v0[1]); w.y = cvt_pk_bf16(v0[2], v0[3]); w.z = cvt_pk_bf16(v1[0], v1[1]); w.w = cvt_pk_bf16(v1[2], v1[3]);
                    *(u32x4*)(rowp + bj * HALF) = w; } }
    }
};
struct EpiBf16S11 : EpiBf16 { static constexpr int WSCALE = 0x74747474; };
struct EpiSwiGLU {
    static constexpr bool PERM = true; static constexpr int WSCALE = 0x7f7f7f7f;
    bf16_t* H; int ldh;
    __device__ __forceinline__ void operator()(const f32x4 (&acc)[2][2][4][2], const Unit& u, int wr, int wc, int fr, int fq) const {
        const int row0 = u.pm * BM + wr * 64 + fr, col0 = u.pn * HALF + wc * 32 + 8 * fq;
#pragma unroll
        for (int ai = 0; ai < 2; ++ai)
#pragma unroll
            for (int m = 0; m < 4; ++m) { bf16_t* rowp = H + (size_t)(row0 + ai * HALF + m * 16) * ldh + col0;
                float h[8];
#pragma unroll
                for (int n = 0; n < 2; ++n)
#pragma unroll
                    for (int j = 0; j < 4; ++j) { const float g = acc[ai][0][m][n][j], up = acc[ai][1][m][n][j]; h[n * 4 + j] = g * up * __builtin_amdgcn_rcpf(1.0f + __expf(-g)); }
                u32x4 w; w.x = cvt_pk_bf16(h[0], h[1]); w.y = cvt_pk_bf16(h[2], h[3]); w.z = cvt_pk_bf16(h[4], h[5]); w.w = cvt_pk_bf16(h[6], h[7]);
                *(u32x4*)rowp = w; }
    }
};

struct EpiF8 {
    static constexpr bool PERM = true; static constexpr int WSCALE = 0x7c7c7c7c;
    unsigned char* O; int ldc; float scale;
    __device__ __forceinline__ void operator()(const f32x4 (&acc)[2][2][4][2], const Unit& u, int wr, int wc, int fr, int fq) const {
        const int row0 = u.pm * BM + wr * 64 + fr, col0 = u.pn * BM + wc * 32 + 8 * fq;
#pragma unroll
        for (int ai = 0; ai < 2; ++ai)
#pragma unroll
            for (int m = 0; m < 4; ++m) { unsigned char* rowp = O + (size_t)(row0 + ai * HALF + m * 16) * ldc + col0;
#pragma unroll
                for (int bj = 0; bj < 2; ++bj) { const f32x4 v0 = acc[ai][bj][m][0] * scale, v1 = acc[ai][bj][m][1] * scale;
                    unsigned w0 = __builtin_amdgcn_cvt_pk_fp8_f32(__builtin_amdgcn_fmed3f(v0[0], -448.f, 448.f), __builtin_amdgcn_fmed3f(v0[1], -448.f, 448.f), 0, false);
                    w0 = __builtin_amdgcn_cvt_pk_fp8_f32(__builtin_amdgcn_fmed3f(v0[2], -448.f, 448.f), __builtin_amdgcn_fmed3f(v0[3], -448.f, 448.f), w0, true);
                    unsigned w1 = __builtin_amdgcn_cvt_pk_fp8_f32(__builtin_amdgcn_fmed3f(v1[0], -448.f, 448.f), __builtin_amdgcn_fmed3f(v1[1], -448.f, 448.f), 0, false);
                    w1 = __builtin_amdgcn_cvt_pk_fp8_f32(__builtin_amdgcn_fmed3f(v1[2], -448.f, 448.f), __builtin_amdgcn_fmed3f(v1[3], -448.f, 448.f), w1, true);
                    *(u32x2*)(rowp + bj * HALF) = (u32x2){w0, w1}; } }
    }
};
__device__ __forceinline__ float clamp448(float x) { return __builtin_amdgcn_fmed3f(x, -448.0f, 448.0f); }
struct EpiSwiGLU8 {
    static constexpr bool PERM = true; static constexpr int WSCALE = 0x7a7a7a7a;
    unsigned char* H; int ldh; float in_scale, out_scale;
    __device__ __forceinline__ void operator()(const f32x4 (&acc)[2][2][4][2], const Unit& u, int wr, int wc, int fr, int fq) const {
        const int row0 = u.pm * BM + wr * 64 + fr, col0 = u.pn * HALF + wc * 32 + 8 * fq;
#pragma unroll
        for (int ai = 0; ai < 2; ++ai)
#pragma unroll
            for (int m = 0; m < 4; ++m) { unsigned char* rowp = H + (size_t)(row0 + ai * HALF + m * 16) * ldh + col0;
                float h[8];
#pragma unroll
                for (int n = 0; n < 2; ++n)
#pragma unroll
                    for (int j = 0; j < 4; ++j) { const float ga = acc[ai][0][m][n][j], ua = acc[ai][1][m][n][j];
                        const float sg = __builtin_amdgcn_rcpf(1.0f + __builtin_amdgcn_exp2f(-ga));
                        h[n * 4 + j] = clamp448(ga * ua * sg); }
                unsigned w0 = __builtin_amdgcn_cvt_pk_fp8_f32(h[0], h[1], 0, false); w0 = __builtin_amdgcn_cvt_pk_fp8_f32(h[2], h[3], w0, true);
                unsigned w1 = __builtin_amdgcn_cvt_pk_fp8_f32(h[4], h[5], 0, false); w1 = __builtin_amdgcn_cvt_pk_fp8_f32(h[6], h[7], w1, true);
                *(u32x2*)rowp = (u32x2){w0, w1}; }
    }
};

#ifndef F8_SCALE_WORD
#define F8_SCALE_WORD 0x7f7f7f7f
#endif
template <bool F8> struct FragT;
struct Frag16 { bf16x8 k[2]; };
template <> struct FragT<false> { typedef Frag16 T; };
template <> struct FragT<true> { typedef i32x8 T; };
__device__ __forceinline__ void frag_load(Frag16& d, const PG8_LAS unsigned char* p) { d.k[0] = *(const PG8_LAS bf16x8*)p; d.k[1] = *(const PG8_LAS bf16x8*)(p + 1024); }
__device__ __forceinline__ void frag_load(i32x8& d, const PG8_LAS unsigned char* p) { const i32x4 lo = *(const PG8_LAS i32x4*)p, hi = *(const PG8_LAS i32x4*)(p + 16); d = __builtin_shufflevector(lo, hi, 0, 1, 2, 3, 4, 5, 6, 7); }
template <int WSC> __device__ __forceinline__ f32x4 frag_mma(const Frag16& b, const Frag16& a, f32x4 c) { c = __builtin_amdgcn_mfma_f32_16x16x32_bf16(b.k[0], a.k[0], c, 0, 0, 0); return __builtin_amdgcn_mfma_f32_16x16x32_bf16(b.k[1], a.k[1], c, 0, 0, 0); }
template <int WSC> __device__ __forceinline__ f32x4 frag_mma(const i32x8& b, const i32x8& a, f32x4 c) {
#if F8_SCALE_WORD
    const int sc = F8_SCALE_WORD, scw = WSC; asm volatile("v_mfma_scale_f32_16x16x128_f8f6f4 %0, %1, %2, %0, %3, %4 op_sel_hi:[0,0,0]" : "+v"(c) : "v"(b), "v"(a), "v"(scw), "v"(sc));
#else
    asm volatile("v_mfma_f32_16x16x128_f8f6f4 %0, %1, %2, %0" : "+v"(c) : "v"(b), "v"(a));
#endif
    return c; }
#ifndef PG8_SP2
#define PG8_SP2 false
#endif
template <class Epi, class Sched, bool F8 = false, bool ALIGN_EPI = true, bool SP2 = PG8_SP2>
__device__ __forceinline__ void gemm_phase(PG8_LAS unsigned char* lds, const Gemm g, const Sched& S, const Epi& E) {
    int tid_ = threadIdx.x; asm volatile("" : "+v"(tid_));
    const int tid = tid_, wid = __builtin_amdgcn_readfirstlane(tid >> 6), lane = tid & 63, wr = wid >> 2, wc = wid & 3, fr = lane & 15, fq = lane >> 4;
    const int K = g.K, rowb = F8 ? K : 2 * K, nt = rowb / 128;
    unsigned voffA[2], voffB[2];
#pragma unroll
    for (int i = 0; i < 2; ++i) { int R, C; stage_rc(tid * 16 + i * 8192, R, C); const int Rb = Epi::PERM ? ((R & ~31) + perm32(R & 31)) : R;
        voffA[i] = (unsigned)(R * rowb + C * 2); voffB[i] = (unsigned)(Rb * rowb + C * 2); }
    const size_t kstep = (size_t)(BK * 2);
    const size_t hstep = (size_t)HALF * rowb;
    const size_t tstep = 2 * hstep;
    const unsigned ldsw = (unsigned)wid * 1024u;
    const int aoff = lds_byte(wr * 64 + fr, fq * (F8 ? 16 : 8)), boff = lds_byte(wc * 32 + fr, fq * (F8 ? 16 : 8));
#define PG8_SA(b, h) (((b) * 2 + (h)) * HTB)
#define PG8_SB(b, h) ((4 + (b) * 2 + (h)) * HTB)
#define PG8_STAGE(bufoff, gbase, voff) do { _Pragma("unroll") for (int _i = 0; _i < 2; ++_i) \
        __builtin_amdgcn_global_load_lds((const unsigned*)((const char*)(gbase) + (voff)[_i]), (PG8_LAS unsigned*)(lds + (bufoff) + ldsw + _i * 8192), 16, 0, 0); } while (0)
#define PG8_LDA(dst, b, h) do { _Pragma("unroll") for (int m = 0; m < 4; ++m) frag_load(dst[m], lds + PG8_SA(b, h) + aoff + m * 2048); } while (0)
#define PG8_LDB(dst, b, h) do { _Pragma("unroll") for (int n = 0; n < 2; ++n) frag_load(dst[n], lds + PG8_SB(b, h) + boff + n * 2048); } while (0)
#define PG8_MMA(ai, bj, At, Bt) do { __builtin_amdgcn_s_setprio(1); _Pragma("unroll") for (int m = 0; m < 4; ++m) _Pragma("unroll") for (int n = 0; n < 2; ++n) \
        acc[ai][bj][m][n] = frag_mma<Epi::WSCALE>(Bt[n], At[m], acc[ai][bj][m][n]); __builtin_amdgcn_s_setprio(0); } while (0)
#define PG8_WAIT_V(n) asm volatile("s_waitcnt vmcnt(" #n ")" ::: "memory")
#define PG8_WAIT_L(n) asm volatile("s_waitcnt lgkmcnt(" #n ")" ::: "memory")
#define PG8_BAR __builtin_amdgcn_s_barrier()
#define PG8_SCHED __builtin_amdgcn_sched_barrier(0)
    Unit cur, nxt; int ui = 0;
    if (!S.next(0, cur)) return;
    f32x4 acc[2][2][4][2];
#pragma unroll
    for (int a = 0; a < 2; ++a)
#pragma unroll
        for (int b = 0; b < 2; ++b)
#pragma unroll
            for (int m = 0; m < 4; ++m)
#pragma unroll
                for (int n = 0; n < 2; ++n) { acc[a][b][m][n] = (f32x4){0.f, 0.f, 0.f, 0.f}; if (F8) asm volatile("" : "+v"(acc[a][b][m][n])); }
    typename FragT<F8>::T At[4], B0[2], B1[2];
    const char* cA = (const char*)g.A + (size_t)cur.pm * tstep; const char* cB = (const char*)g.Bt + (size_t)cur.pb * tstep;
    if constexpr (SP2) {
        PG8_STAGE(PG8_SB(0, 0), cB, voffB); PG8_STAGE(PG8_SB(0, 1), cB + hstep, voffB); PG8_STAGE(PG8_SA(0, 0), cA, voffA); PG8_STAGE(PG8_SA(0, 1), cA + hstep, voffA);
        if (wr == 1) PG8_BAR;
        PG8_WAIT_V(2); PG8_BAR;
        PG8_STAGE(PG8_SB(1, 0), cB + kstep, voffB); PG8_STAGE(PG8_SA(1, 0), cA + kstep, voffA); PG8_STAGE(PG8_SB(1, 1), cB + hstep + kstep, voffB);
        PG8_WAIT_V(6); PG8_BAR;
    } else {
    PG8_STAGE(PG8_SB(0, 0), cB, voffB); PG8_STAGE(PG8_SA(0, 0), cA, voffA); PG8_STAGE(PG8_SB(0, 1), cB + hstep, voffB); PG8_STAGE(PG8_SA(0, 1), cA + hstep, voffA);
    if (wr == 1) PG8_BAR;
    PG8_WAIT_V(4); PG8_BAR;
    PG8_STAGE(PG8_SB(1, 0), cB + kstep, voffB); PG8_STAGE(PG8_SA(1, 0), cA + kstep, voffA); PG8_STAGE(PG8_SB(1, 1), cB + hstep + kstep, voffB);
    PG8_WAIT_V(6); PG8_BAR;
    }
    for (;;) {
        const bool has_next = S.next(ui + 1, nxt);
        const char* nA = has_next ? (const char*)g.A + (size_t)nxt.pm * tstep : cA; const char* nB = has_next ? (const char*)g.Bt + (size_t)nxt.pb * tstep : cB;
        for (int t = 0; t < nt; t += 2) {
            const bool last = (t == nt - 2);
            const char* a1 = cA + (size_t)(t + 1) * kstep;
            const char* a2 = last ? nA : cA + (size_t)(t + 2) * kstep; const char* b2 = last ? nB : cB + (size_t)(t + 2) * kstep;
            const char* a3 = a2 + kstep; const char* b3 = b2 + kstep;
            if constexpr (SP2) {
            PG8_LDB(B0, 0, 0); PG8_LDB(B1, 0, 1); PG8_SCHED; PG8_LDA(At, 0, 0); PG8_STAGE(PG8_SA(1, 1), a1 + hstep, voffA);
            PG8_WAIT_V(8); PG8_WAIT_L(0); PG8_BAR; PG8_MMA(0, 0, At, B0); PG8_MMA(0, 1, At, B1); PG8_BAR; PG8_SCHED;
            PG8_LDA(At, 0, 1); PG8_STAGE(PG8_SB(0, 0), b2, voffB); PG8_STAGE(PG8_SB(0, 1), b2 + hstep, voffB); PG8_STAGE(PG8_SA(0, 0), a2, voffA);
            PG8_WAIT_V(8); PG8_WAIT_L(0); PG8_BAR; PG8_MMA(1, 0, At, B0); PG8_MMA(1, 1, At, B1); PG8_BAR; PG8_SCHED;
            PG8_LDB(B0, 1, 0); PG8_LDB(B1, 1, 1); PG8_SCHED; PG8_LDA(At, 1, 0); PG8_STAGE(PG8_SA(0, 1), a2 + hstep, voffA);
            PG8_WAIT_V(8); PG8_WAIT_L(0); PG8_BAR; PG8_MMA(0, 0, At, B0); PG8_MMA(0, 1, At, B1); PG8_BAR; PG8_SCHED;
            PG8_LDA(At, 1, 1); PG8_STAGE(PG8_SB(1, 0), b3, voffB); PG8_STAGE(PG8_SB(1, 1), b3 + hstep, voffB); PG8_STAGE(PG8_SA(1, 0), a3, voffA);
            PG8_WAIT_V(8); PG8_WAIT_L(0); PG8_BAR; PG8_MMA(1, 0, At, B0); PG8_MMA(1, 1, At, B1); PG8_BAR; PG8_SCHED;
            } else {
            PG8_LDB(B0, 0, 0); PG8_SCHED; PG8_LDA(At, 0, 0); PG8_STAGE(PG8_SA(1, 1), a1 + hstep, voffA);
            PG8_WAIT_L(8); PG8_BAR; PG8_WAIT_L(0); PG8_MMA(0, 0, At, B0); PG8_BAR; PG8_SCHED;
            PG8_LDB(B1, 0, 1); PG8_STAGE(PG8_SB(0, 0), b2, voffB);
            PG8_BAR; PG8_WAIT_L(0); PG8_MMA(0, 1, At, B1); PG8_BAR;
            PG8_LDA(At, 0, 1); PG8_STAGE(PG8_SA(0, 0), a2, voffA);
            PG8_BAR; PG8_WAIT_L(0); PG8_MMA(1, 0, At, B0); PG8_BAR; PG8_SCHED;
            PG8_STAGE(PG8_SB(0, 1), b2 + hstep, voffB);
            PG8_WAIT_V(6); PG8_BAR; PG8_MMA(1, 1, At, B1); PG8_BAR;
            PG8_LDB(B0, 1, 0); PG8_SCHED; PG8_LDA(At, 1, 0); PG8_STAGE(PG8_SA(0, 1), a2 + hstep, voffA);
            PG8_WAIT_L(8); PG8_BAR; PG8_WAIT_L(0); PG8_MMA(0, 0, At, B0); PG8_BAR; PG8_SCHED;
            PG8_LDB(B1, 1, 1); PG8_STAGE(PG8_SB(1, 0), b3, voffB);
            PG8_BAR; PG8_WAIT_L(0); PG8_MMA(0, 1, At, B1); PG8_BAR;
            PG8_LDA(At, 1, 1); PG8_STAGE(PG8_SA(1, 0), a3, voffA);
            PG8_BAR; PG8_WAIT_L(0); PG8_MMA(1, 0, At, B0); PG8_BAR; PG8_SCHED;
            PG8_STAGE(PG8_SB(1, 1), b3 + hstep, voffB);
            PG8_WAIT_V(6); PG8_BAR; PG8_MMA(1, 1, At, B1); PG8_BAR;
            }
        }
        if constexpr (ALIGN_EPI) { if (wr == 0) PG8_BAR; }
        if (F8) asm volatile("s_nop 15\n\ts_nop 15" ::: "memory");
        E(acc, cur, wr, wc, fr, fq);
        if (!has_next) break;
#pragma unroll
        for (int a = 0; a < 2; ++a)
#pragma unroll
            for (int b = 0; b < 2; ++b)
#pragma unroll
                for (int m = 0; m < 4; ++m)
#pragma unroll
                    for (int n = 0; n < 2; ++n) { acc[a][b][m][n] = (f32x4){0.f, 0.f, 0.f, 0.f}; if (F8) asm volatile("" : "+v"(acc[a][b][m][n])); }
        cur = nxt; cA = nA; cB = nB; ++ui;
        if constexpr (ALIGN_EPI) { if (wr == 1) PG8_BAR; }
    }
    PG8_WAIT_V(0);
    if constexpr (!ALIGN_EPI) { if (wr == 0) PG8_BAR; }
    PG8_BAR;
#undef PG8_SA
#undef PG8_SB
#undef PG8_STAGE
#undef PG8_LDA
#undef PG8_LDB
#undef PG8_MMA
#undef PG8_WAIT_V
#undef PG8_WAIT_L
#undef PG8_BAR
#undef PG8_SCHED
}
}

constexpr int NWAVES = 8, NTHR = 512;
constexpr int D = 1024, NB = 16, T = 2048, TC = 256;
constexpr int M_LAT = NB * T, M_CTX = NB * TC, M_ALL = M_LAT + M_CTX;
constexpr int INW = 3328, RW_IN = 1760;
constexpr int C_R = 0, C_GG = 512, C_Q = 1024, C_K = 1280, C_V = 1792, C_WDF = 2304, C_WDB = 2336, C_ADF = 2368, C_ADB = 2400, C_GD = 2432;
constexpr int C_KG = 2528, C_VG = 2784, C_GADF = 3296, C_GADB = 3312;
constexpr int MU_SHIFT = 768;
__host__ __device__ constexpr int zcol_of_src(int n) {
    return n < 512 ? n : n < 1760 ? n + 768 : n < 2016 ? n - 736 : n < 2784 ? n + 512 : n < 3296 ? n - 2272 : n; }
constexpr int NE = 16, FF = 2816, CAP = 256;
constexpr float LN_EPS = 1e-5f, GN_EPS = 64e-5f, GLA_EPS = 1e-5f;
constexpr float DN_ALPHA = 1.189207115002721f;
enum { I_X = 0, I_C, I_CTX, I_CCTX, I_ADAW, I_ADAB, I_WIN, I_MU, I_W0, I_W2, I_A0, I_A2, I_G2, I_KK, I_KA, I_RK, I_GNW, I_GNB, I_GLA2, I_GLAB, I_GLNW, I_WOUT,
       I_LN1G, I_LN1B, I_RTW, I_EXG, I_EXU, I_EXD, I_LN2G, I_LN2B, N_IN };

constexpr size_t MiB = 1u << 20;
constexpr size_t WS_CTL = 0, CTL_ZERO_BYTES = 32768;
constexpr size_t WS_MOD = 1 * MiB;
constexpr size_t WS_WIN = 2 * MiB;
constexpr size_t WS_WOUT = 9 * MiB;
constexpr size_t WS_G2T = 11 * MiB;
constexpr size_t WS_WGU = 12 * MiB;
constexpr size_t WS_WD = 100 * MiB;
constexpr size_t WS_H0 = 276 * MiB;
constexpr size_t WS_O = 276 * MiB;
constexpr size_t WS_Z = 404 * MiB;
constexpr size_t WS_CB = 638 * MiB;
constexpr size_t WS_MIX = 640 * MiB;
constexpr size_t WS_PROJ = 276 * MiB;
constexpr size_t WS_XIN = 276 * MiB;
constexpr size_t WS_HH = 340 * MiB;
constexpr size_t WS_YE = 516 * MiB;
constexpr size_t WS_X1 = 580 * MiB;
constexpr size_t WS_H2 = 644 * MiB;
constexpr size_t WS_AFF = 676 * MiB;
constexpr size_t WS_SELPOS = 678 * MiB;
constexpr size_t WS_GATE = 680 * MiB;
constexpr size_t WS_END = 704 * MiB;
#ifndef INPROJ_F8
#define INPROJ_F8 0
#endif
constexpr float HA_SCALE = 8.0f, WIN_SCALE = 256.0f;
#ifndef OUTPROJ_F8
#define OUTPROJ_F8 1
#endif
constexpr float MIX_SCALE = 8.0f, WOUT_SCALE = 256.0f;
constexpr float XIN_L = 1.44269504088896f;
constexpr float W1_SCALE = 32.0f, W2_SCALE = 64.0f, H_SCALE = XIN_L * XIN_L, YE_SCALE = H_SCALE * W2_SCALE / 8.0f;
constexpr int CW_TMO = 0;
constexpr int CW_BAR = 4096;

constexpr int RING_BYTES = 131072;
constexpr int LDSCTL_OFF = RING_BYTES, MISC_OFF = LDSCTL_OFF + 320;
constexpr int LDS_BYTES = 147456;

#define LAS __attribute__((address_space(3)))
typedef unsigned short bf16;
typedef unsigned v4u __attribute__((ext_vector_type(4)));
typedef unsigned v2u __attribute__((ext_vector_type(2)));
typedef float f32x4 __attribute__((ext_vector_type(4)));
typedef float f32x2 __attribute__((ext_vector_type(2)));
typedef short bf16x8 __attribute__((ext_vector_type(8)));
#define RLX_AGENT __ATOMIC_RELAXED, __HIP_MEMORY_SCOPE_AGENT
typedef __bf16 hwbf16x2 __attribute__((ext_vector_type(2)));
__device__ __forceinline__ unsigned pk2(float lo, float hi) { const f32x2 v = {lo, hi}; return __builtin_bit_cast(unsigned, __builtin_convertvector(v, hwbf16x2)); }
__device__ __forceinline__ unsigned f2bf(float f) { return pk2(f, f) & 0xffffu; }
__device__ __forceinline__ float bflo(unsigned w) { return __builtin_bit_cast(float, w << 16); }
__device__ __forceinline__ float bfhi(unsigned w) { return __builtin_bit_cast(float, w & 0xffff0000u); }
__device__ __forceinline__ float bf1(bf16 h) { return __builtin_bit_cast(float, ((unsigned)h) << 16); }
__device__ __forceinline__ void unpack4_fp8(unsigned w, float* f) { f[0] = __builtin_amdgcn_cvt_f32_fp8(w, 0); f[1] = __builtin_amdgcn_cvt_f32_fp8(w, 1); f[2] = __builtin_amdgcn_cvt_f32_fp8(w, 2); f[3] = __builtin_amdgcn_cvt_f32_fp8(w, 3); }
__device__ __forceinline__ void unpack8(const v4u w, float* f) { f[0] = bflo(w.x); f[1] = bfhi(w.x); f[2] = bflo(w.y); f[3] = bfhi(w.y); f[4] = bflo(w.z); f[5] = bfhi(w.z); f[6] = bflo(w.w); f[7] = bfhi(w.w); }
template <int CTRL> __device__ __forceinline__ float dppmov(float v) { return __builtin_bit_cast(float, __builtin_amdgcn_update_dpp(0, __builtin_bit_cast(int, v), CTRL, 0xF, 0xF, true)); }
__device__ __forceinline__ float red4(float x) { x += dppmov<0xB1>(x); x += dppmov<0x4E>(x); return x; }
__device__ __forceinline__ float red8(float x) { x = red4(x); x += dppmov<0x141>(x); return x; }
__device__ __forceinline__ float red16(float x) { x = red8(x); x += dppmov<0x140>(x); return x; }
__device__ __forceinline__ float wave_sum(float v) {
#pragma unroll
    for (int o = 1; o < 64; o <<= 1) v += __shfl_xor(v, o);
    return v;
}
__device__ __forceinline__ float wave_sum_dpp(float x) {
    x += dppmov<0xB1>(x); x += dppmov<0x4E>(x); x += dppmov<0x124>(x); x += dppmov<0x128>(x);
    x += __builtin_bit_cast(float, __builtin_amdgcn_update_dpp(0, __builtin_bit_cast(int, x), 0x142, 0xA, 0xF, false));
    x += __builtin_bit_cast(float, __builtin_amdgcn_update_dpp(0, __builtin_bit_cast(int, x), 0x143, 0xC, 0xF, false));
    return __builtin_bit_cast(float, __builtin_amdgcn_readlane(__builtin_bit_cast(int, x), 63));
}
__device__ __forceinline__ float fexp(float x) { return __builtin_amdgcn_exp2f(x * 1.44269504088896f); }
__device__ __forceinline__ float fsigmoid(float x) { return __builtin_amdgcn_rcpf(1.0f + fexp(-x)); }
__device__ __forceinline__ float sigmoidf_(float x) { return 1.0f / (1.0f + expf(-x)); }

#define XB_TMO      128
#define XB_XCNT(j)  (256  + 64 * (j))
#define XB_XSUB(j)  (1280 + 64 * (j))
#define XB_XGEN(j)  (2304 + 64 * (j))
#define XB_TOP      3328
#define XB_TOPGEN   3392
#define XCD_BAR_WORDS 3456
#define XB_SPIN_CAP (1u << 18)
__device__ __forceinline__ unsigned xb_ld(unsigned* p)              { return __hip_atomic_load(p, __ATOMIC_RELAXED, __HIP_MEMORY_SCOPE_AGENT); }
__device__ __forceinline__ unsigned xb_add(unsigned* p, unsigned v) { return __hip_atomic_fetch_add(p, v, __ATOMIC_RELAXED, __HIP_MEMORY_SCOPE_AGENT); }
__device__ __forceinline__ unsigned xb_xcc_id() { return (unsigned)__builtin_amdgcn_s_getreg((3 << 11) | 20) & 0xFu; }
#define XB_SPIN(cond, bar) do { unsigned _sp = 0; while (cond) { __builtin_amdgcn_s_sleep(1); \
    if ((++_sp & 255u) == 0u) { if (xb_ld(&(bar)[XB_TMO])) break; if (_sp > XB_SPIN_CAP) { atomicAdd(&(bar)[XB_TMO], 1u); break; } } } } while (0)
struct XcdBarrier { unsigned* bar; unsigned x; volatile LAS unsigned* st; };
__device__ __forceinline__ XcdBarrier xcd_barrier_post(unsigned* bar, volatile LAS unsigned* st) {
    XcdBarrier b; b.bar = bar; b.x = xb_xcc_id(); b.st = st;
    if (threadIdx.x == 0) (void)xb_add(&bar[XB_XCNT(b.x)], 1u);
    return b;
}
__device__ __forceinline__ void xcd_barrier_complete(unsigned* bar, unsigned x, unsigned& nloc, unsigned& nx) {
    const unsigned G = gridDim.x * gridDim.y * gridDim.z;
    unsigned sum, cnt, mine, sp = 0u;
    for (;;) {
        sum = 0u; cnt = 0u; mine = 0u;
#pragma unroll
        for (unsigned j = 0; j < 16; ++j) { const unsigned c = xb_ld(&bar[XB_XCNT(j)]); sum += c; cnt += (c > 0u) ? 1u : 0u; mine = (j == x) ? c : mine; }
        if (sum == G) break;
        __builtin_amdgcn_s_sleep(1);
        if ((++sp & 255u) == 0u) { if (xb_ld(&bar[XB_TMO])) break; if (sp > XB_SPIN_CAP) { atomicAdd(&bar[XB_TMO], 1u); break; } }
    }
    nloc = mine > 0u ? mine : 1u; nx = cnt > 0u ? cnt : 1u;
}
__device__ __forceinline__ void xcd_barrier(const XcdBarrier& b) {
    asm volatile("s_waitcnt vmcnt(0)" ::: "memory");
    __syncthreads();
    if (threadIdx.x == 0) {
        unsigned* bar = b.bar;
        __builtin_amdgcn_s_waitcnt(0);
        unsigned nloc = b.st[0], nx = b.st[1];
        if (nloc == 0u) { xcd_barrier_complete(bar, b.x, nloc, nx); b.st[0] = nloc; b.st[1] = nx; }
        const unsigned old = xb_add(&bar[XB_XSUB(b.x)], 1u);
        const unsigned gen = old / nloc;
        if (old + 1u == (gen + 1u) * nloc) {
            __builtin_amdgcn_fence(__ATOMIC_RELEASE, "agent");
            asm volatile("s_waitcnt vmcnt(0)" ::: "memory");
            const unsigned og = xb_add(&bar[XB_TOP], 1u);
            const unsigned tg = og / nx;
            if (og + 1u == (tg + 1u) * nx) xb_add(&bar[XB_TOPGEN], 1u);
            else XB_SPIN(xb_ld(&bar[XB_TOPGEN]) == tg, bar);
            __builtin_amdgcn_fence(__ATOMIC_ACQUIRE, "agent");
            xb_add(&bar[XB_XGEN(b.x)], 1u);
            asm volatile("s_waitcnt vmcnt(0)" ::: "memory");
        } else {
            XB_SPIN(xb_ld(&bar[XB_XGEN(b.x)]) == gen, bar);
            __builtin_amdgcn_fence(__ATOMIC_ACQUIRE, "agent");
            asm volatile("s_waitcnt vmcnt(0)" ::: "memory");
        }
    }
    __syncthreads();
}

struct Args { const float* in[N_IN]; float* out; unsigned char* ws; int ph_lo, ph_hi; };
struct Frame {
    LAS unsigned char* lds;
    int tid, lane, wave, G, bid;
    const float* const* in; float* out; unsigned char* ws;
};
#define WSP(T_, off) ((T_*)(F.ws + (off)))

__device__ __forceinline__ int zrow_lat(int b, int t) { return b * T + t; }
__device__ __forceinline__ int zrow_ctx(int b, int t) { return M_LAT + b * TC + t; }

struct Nbr { int r[4]; float m[4]; float coef; };
__device__ __forceinline__ Nbr nbr_of(int row) {
    Nbr n;
    if (row < M_LAT) { const int t = row & (T - 1), gx = t & 63, gy = t >> 6;
        const bool l = gx > 0, r = gx < 63, u = gy > 0, d = gy < 31;
        n.r[0] = l ? row - 1 : row; n.r[1] = r ? row + 1 : row; n.r[2] = u ? row - 64 : row; n.r[3] = d ? row + 64 : row;
        n.m[0] = l ? 1.f : 0.f; n.m[1] = r ? 1.f : 0.f; n.m[2] = u ? 1.f : 0.f; n.m[3] = d ? 1.f : 0.f; n.coef = 0.25f;
    } else { const int t = (row - M_LAT) & (TC - 1); const bool l = t > 0, r = t < TC - 1;
        n.r[0] = l ? row - 1 : row; n.r[1] = r ? row + 1 : row; n.r[2] = row; n.r[3] = row;
        n.m[0] = l ? 1.f : 0.f; n.m[1] = r ? 1.f : 0.f; n.m[2] = 0.f; n.m[3] = 0.f; n.coef = 0.5f; }
    return n;
}
__device__ __forceinline__ void shift8(const v4u c, const v4u* nb, const Nbr& n, const float* mu8, float* out) {
    float zc[8], acc[8], t[8]; unpack8(c, zc);
#pragma unroll
    for (int e = 0; e < 8; ++e) acc[e] = 0.f;
#pragma unroll
    for (int q = 0; q < 4; ++q) { unpack8(nb[q], t);
#pragma unroll
        for (int e = 0; e < 8; ++e) acc[e] += n.m[q] * t[e]; }
#pragma unroll
    for (int e = 0; e < 8; ++e) out[e] = zc[e] + (n.coef * acc[e] - zc[e]) * mu8[e];
}

constexpr int P0_MOD_COLS = 32, P0_MOD_ITEMS = 6 * D / P0_MOD_COLS;
__device__ __forceinline__ void p0_mod_item(Frame& F, int item) {
    LAS float* S = (LAS float*)F.lds;
    LAS float* RED = S + 17 * 1024;
    const float* c = F.in[I_C]; const float* cc = F.in[I_CCTX]; const float* W = F.in[I_ADAW]; const float* bias = F.in[I_ADAB];
    const int kg = F.tid >> 5, col = F.tid & 31, colc = col < P0_MOD_COLS ? col : P0_MOD_COLS - 1, n0 = item * P0_MOD_COLS;
    float wall[64];
#pragma unroll
    for (int q = 0; q < 64; ++q) wall[q] = W[(size_t)(kg * 64 + q) * (6 * D) + n0 + colc];
    { float cv[34];
#pragma unroll
      for (int q = 0; q < 34; ++q) { const int i = F.tid + NTHR * q; cv[q] = q < 32 ? c[i] : cc[i - 16 * 1024]; }
#pragma unroll
      for (int q = 0; q < 34; ++q) S[F.tid + NTHR * q] = cv[q] * fsigmoid(cv[q]); }
    __syncthreads();
    float acc[17];
#pragma unroll
    for (int r = 0; r < 17; ++r) acc[r] = 0.f;
#pragma unroll
    for (int k8 = 0; k8 < 8; ++k8) { const int k = kg * 64 + 8 * k8;
#pragma unroll
        for (int r = 0; r < 17; ++r) { const f32x4 s0 = *(const LAS f32x4*)(S + r * 1024 + k), s1 = *(const LAS f32x4*)(S + r * 1024 + k + 4);
            float a = acc[r];
            a = __builtin_fmaf(s0.x, wall[8 * k8], a); a = __builtin_fmaf(s0.y, wall[8 * k8 + 1], a); a = __builtin_fmaf(s0.z, wall[8 * k8 + 2], a); a = __builtin_fmaf(s0.w, wall[8 * k8 + 3], a);
            a = __builtin_fmaf(s1.x, wall[8 * k8 + 4], a); a = __builtin_fmaf(s1.y, wall[8 * k8 + 5], a); a = __builtin_fmaf(s1.z, wall[8 * k8 + 6], a); a = __builtin_fmaf(s1.w, wall[8 * k8 + 7], a);
            acc[r] = a; }
    }
#pragma unroll
    for (int r = 0; r < 17; ++r) RED[(kg * 17 + r) * 32 + col] = acc[r];
    __syncthreads();
    float* mod = WSP(float, WS_MOD);
    for (int i = F.tid; i < 17 * 32; i += NTHR) { const int r = i >> 5, cl = i & 31; if (cl < P0_MOD_COLS) { float s = bias[n0 + cl];
#pragma unroll
        for (int g = 0; g < 16; ++g) s += RED[(g * 17 + r) * 32 + cl];
        mod[r * (6 * D) + n0 + cl] = s; } }
    __syncthreads();
}
__device__ __forceinline__ void p0_transpose_item(const float* W, int N, int K, bf16* WT, int drow0, int k0, int n0, LAS float* scr, int lane, float wsc = 1.0f) {
    { float wv_[32];
#pragma unroll
      for (int i = 0; i < 32; ++i) { const int kk = 2 * i + (lane >> 5); wv_[i] = W[(size_t)(k0 + kk) * N + n0 + (lane & 31)]; }
#pragma unroll
      for (int i = 0; i < 32; ++i) { const int kk = 2 * i + (lane >> 5); scr[kk * 33 + (lane & 31)] = wv_[i] * wsc; } }
    asm volatile("s_waitcnt vmcnt(0) lgkmcnt(0)" ::: "memory");
    const int c = lane & 7;
#pragma unroll
    for (int j = 0; j < 4; ++j) { const int n = (lane >> 3) + 8 * j; const LAS float* s = scr + (8 * c) * 33 + n;
        v4u o; o.x = pk2(s[0 * 33], s[1 * 33]); o.y = pk2(s[2 * 33], s[3 * 33]); o.z = pk2(s[4 * 33], s[5 * 33]); o.w = pk2(s[6 * 33], s[7 * 33]);
        *(v4u*)(WT + (size_t)(drow0 + n) * K + k0 + 8 * c) = o; }
    asm volatile("s_waitcnt lgkmcnt(0)" ::: "memory");
}
__device__ __forceinline__ float clamp448f(float x) { return __builtin_amdgcn_fmed3f(x, -448.0f, 448.0f); }
__device__ __forceinline__ unsigned pk4_fp8(float a, float b, float c, float d) { unsigned w = __builtin_amdgcn_cvt_pk_fp8_f32(a, b, 0, false); return __builtin_amdgcn_cvt_pk_fp8_f32(c, d, w, true); }
__device__ __forceinline__ void p0_transpose_item_f8(const float* W, int N, int K, unsigned char* WT, int drow0, int k0, int n0, float scale, LAS float* scr, int lane) {
    { float wv_[32];
#pragma unroll
      for (int i = 0; i < 32; ++i) { const int kk = 2 * i + (lane >> 5); wv_[i] = W[(size_t)(k0 + kk) * N + n0 + (lane & 31)]; }
#pragma unroll
      for (int i = 0; i < 32; ++i) { const int kk = 2 * i + (lane >> 5); scr[kk * 33 + (lane & 31)] = wv_[i]; } }
    asm volatile("s_waitcnt vmcnt(0) lgkmcnt(0)" ::: "memory");
    const int n = lane & 31, hf = lane >> 5; const LAS float* sp = scr + (32 * hf) * 33 + n;
    unsigned w[8];
#pragma unroll
    for (int q = 0; q < 8; ++q) w[q] = pk4_fp8(sp[(4 * q) * 33] * scale, sp[(4 * q + 1) * 33] * scale, sp[(4 * q + 2) * 33] * scale, sp[(4 * q + 3) * 33] * scale);
    v4u* dst = (v4u*)(WT + (size_t)(drow0 + n) * K + k0 + 32 * hf);
    dst[0] = (v4u){w[0], w[1], w[2], w[3]}; dst[1] = (v4u){w[4], w[5], w[6], w[7]};
    asm volatile("s_waitcnt lgkmcnt(0)" ::: "memory");
}
__device__ __forceinline__ void p0_prologue(Frame& F, int part = 0) {
    __syncthreads();
    if (part != 2) for (int it = F.bid; it < P0_MOD_ITEMS; it += F.G) p0_mod_item(F, it);
    __syncthreads();
    if (part == 1) return;
    LAS float* scr = (LAS float*)(F.lds + F.wave * 16384);
    const int gw = F.bid * NWAVES + F.wave, NGW = F.G * NWAVES;
#ifndef SIDEJOB
#define SIDEJOB 1
#endif
    constexpr int I_IN = (D / 64) * (INW / 32), I_OUT = (D / 64) * (D / 32), I_GU = (D / 64) * (FF / 32), I_DN = (FF / 64) * (D / 32);
    constexpr int NITEMS = I_IN + I_OUT + (SIDEJOB ? 0 : NE * (2 * I_GU + I_DN));
    for (int it = gw; it < NITEMS; it += NGW) {
        int r = it;
        if (r < I_IN) { const int nblk = INW / 32, kb = r / nblk, nb = r % nblk;
#if INPROJ_F8
            p0_transpose_item_f8(F.in[I_WIN], INW, D, WSP(unsigned char, WS_WIN), zcol_of_src(32 * nb), 64 * kb, 32 * nb, WIN_SCALE, scr, F.lane);
#else
            p0_transpose_item(F.in[I_WIN], INW, D, WSP(bf16, WS_WIN), zcol_of_src(32 * nb), 64 * kb, 32 * nb, scr, F.lane, (32 * nb >= RW_IN && 32 * nb < RW_IN + 256) ? 0.125f : 1.0f);
#endif
            continue; } r -= I_IN;
        if (r < I_OUT) { const int nblk = D / 32, kb = r / nblk, nb = r % nblk;
#if OUTPROJ_F8
            p0_transpose_item_f8(F.in[I_WOUT], D, D, WSP(unsigned char, WS_WOUT), 32 * nb, 64 * kb, 32 * nb, WOUT_SCALE, scr, F.lane);
#else
            p0_transpose_item(F.in[I_WOUT], D, D, WSP(bf16, WS_WOUT), 32 * nb, 64 * kb, 32 * nb, scr, F.lane);
#endif
            continue; } r -= I_OUT;
        const int e = r / (2 * I_GU + I_DN); r -= e * (2 * I_GU + I_DN);
        if (r < 2 * I_GU) { const int up = r >= I_GU ? 1 : 0; r -= up * I_GU; const int nblk = FF / 32, kb = r / nblk, nb = r % nblk, n0 = 32 * nb;
            const float* src = (up ? F.in[I_EXU] : F.in[I_EXG]) + (size_t)e * D * FF;
            const int drow = e * (2 * FF) + 256 * (n0 >> 7) + 128 * up + (n0 & 127);
            p0_transpose_item_f8(src, FF, D, WSP(unsigned char, WS_WGU), drow, 64 * kb, n0, W1_SCALE, scr, F.lane); continue; }
        r -= 2 * I_GU;
        { const int nblk = D / 32, kb = r / nblk, nb = r % nblk;
          p0_transpose_item_f8(F.in[I_EXD] + (size_t)e * FF * D, D, FF, WSP(unsigned char, WS_WD), e * D + 32 * nb, 64 * kb, 32 * nb, W2_SCALE, scr, F.lane); }
    }
    { const float* g2 = F.in[I_G2]; bf16* g2t = WSP(bf16, WS_G2T);
      for (int i = F.bid * NTHR + F.tid; i < 512 * 96; i += F.G * NTHR) { const int n = i / 96, k = i % 96; g2t[i] = (bf16)f2bf(g2[k * 512 + n]); } }
}

__device__ __forceinline__ const float* p1_row(Frame& F, int m) { return m < M_LAT ? F.in[I_X] + (size_t)m * D : F.in[I_CTX] + (size_t)(m - M_LAT) * D; }
__device__ __forceinline__ void p1_ln_mod(Frame& F) {
    const int gw = F.bid * NWAVES + F.wave, NGW = F.G * NWAVES, RPW = (M_ALL + NGW - 1) / NGW;
    const float* mod = WSP(float, WS_MOD); bf16* H0 = WSP(bf16, WS_H0);
    const int r0 = gw * RPW, r1 = r0 + RPW < M_ALL ? r0 + RPW : M_ALL;
#define P1_LOAD(q_, m_) do { const f32x4* xr_ = (const f32x4*)p1_row(F, (m_)) + F.lane; _Pragma("unroll") for (int j = 0; j < 4; ++j) q_[j] = xr_[64 * j]; } while (0)
#define P1_PROC(q_, m_) do { const int mm_ = (m_); f32x4 v[4]; float s = 0.f; \
        _Pragma("unroll") for (int j = 0; j < 4; ++j) { v[j] = q_[j]; s += (v[j].x + v[j].y) + (v[j].z + v[j].w); } \
        const float mean = wave_sum_dpp(s) * (1.f / D); float s2 = 0.f; \
        _Pragma("unroll") for (int j = 0; j < 4; ++j) { v[j] = v[j] - mean; s2 += (v[j].x * v[j].x + v[j].y * v[j].y) + (v[j].z * v[j].z + v[j].w * v[j].w); } \
        const float rstd = __builtin_amdgcn_rsqf(wave_sum_dpp(s2) * (1.f / D) + LN_EPS); \
        unsigned long long* o8 = (unsigned long long*)(H0 + (size_t)mm_ * D) + F.lane; \
        _Pragma("unroll") for (int j = 0; j < 4; ++j) { const f32x4 h = v[j] * rstd * (scv[j] + 1.0f) + shv[j]; \
            o8[64 * j] = (unsigned long long)pk2(h.x, h.y) | ((unsigned long long)pk2(h.z, h.w) << 32); } } while (0)
    if (NGW == 2048) {
        { const int b = gw >> 7, m0 = (b << 11) + 16 * (gw & 127);
          const f32x4* sh = (const f32x4*)(mod + (size_t)b * 6 * D) + F.lane; const f32x4* sc = (const f32x4*)(mod + (size_t)b * 6 * D + D) + F.lane;
          f32x4 shv[4], scv[4];
#pragma unroll
          for (int j = 0; j < 4; ++j) { shv[j] = sh[64 * j]; scv[j] = sc[64 * j]; }
          f32x4 q[3][4];
          P1_LOAD(q[0], m0); P1_LOAD(q[1], m0 + 1); P1_LOAD(q[2], m0 + 2);
#pragma unroll
          for (int i = 0; i < 16; ++i) { P1_PROC(q[i % 3], m0 + i); if (i + 3 < 16) P1_LOAD(q[i % 3], m0 + i + 3); } }
        { const int m0 = M_LAT + 2 * gw;
          const f32x4* sh = (const f32x4*)(mod + (size_t)16 * 6 * D) + F.lane; const f32x4* sc = (const f32x4*)(mod + (size_t)16 * 6 * D + D) + F.lane;
          f32x4 shv[4], scv[4];
#pragma unroll
          for (int j = 0; j < 4; ++j) { shv[j] = sh[64 * j]; scv[j] = sc[64 * j]; }
          f32x4 q[2][4];
          P1_LOAD(q[0], m0); P1_LOAD(q[1], m0 + 1);
          P1_PROC(q[0], m0); P1_PROC(q[1], m0 + 1); }
    } else
    for (int s0 = r0; s0 < r1; ) {
        const bool lat = s0 < M_LAT; const int mr = lat ? (s0 >> 11) : 16;
        const int bend = lat ? ((s0 >> 11) + 1) << 11 : M_ALL, send = bend < r1 ? bend : r1, last = send - 1;
        const f32x4* sh = (const f32x4*)(mod + (size_t)mr * 6 * D) + F.lane; const f32x4* sc = (const f32x4*)(mod + (size_t)mr * 6 * D + D) + F.lane;
        f32x4 shv[4], scv[4];
#pragma unroll
        for (int j = 0; j < 4; ++j) { shv[j] = sh[64 * j]; scv[j] = sc[64 * j]; }
        f32x4 q0[4], q1[4], q2[4];
        P1_LOAD(q0, s0); P1_LOAD(q1, s0 + 1 < last ? s0 + 1 : last); P1_LOAD(q2, s0 + 2 < last ? s0 + 2 : last);
        for (int m = s0; m < send; m += 3) {
            P1_PROC(q0, m);                            P1_LOAD(q0, m + 3 < last ? m + 3 : last);
            P1_PROC(q1, m + 1 < last ? m + 1 : last);  P1_LOAD(q1, m + 4 < last ? m + 4 : last);
            P1_PROC(q2, m + 2 < last ? m + 2 : last);  P1_LOAD(q2, m + 5 < last ? m + 5 : last);
        }
        s0 = send;
    }
#undef P1_LOAD
#undef P1_PROC
}

__device__ __forceinline__ int scan_base_row(int n, int dir, int b) { if (n < 16) { const int ci = dir ? 15 - n : n; return zrow_ctx(b, 16 * ci); } const int m = n - 16, li = dir ? 127 - m : m; return zrow_lat(b, 16 * li); }
__device__ __forceinline__ float dot4(const f32x4 a, const f32x4 b) { return (a.x * b.x + a.y * b.y) + (a.z * b.z + a.w * b.w); }
constexpr int SC_ALD = 72, SC_WLD = 40;
__device__ __forceinline__ float pair_red16(const float a0, const float a1, const bool odd) {
    float t = odd ? a1 : a0; const float u = odd ? a0 : a1;
    t += dppmov<0xB1>(u); t += dppmov<0x4E>(t); t += dppmov<0x124>(t); t += dppmov<0x128>(t);
    return t;
}
__device__ __forceinline__ float opq(float x) { asm("" : "+v"(x)); return x; }
struct S8 { float a[8]; };
template <bool LAT>
__device__ __forceinline__ void scan_steps(const LAS float* VEC, LAS float* YB, const int dir, const int kg, const int row0, S8& S) {
    const int sstr = dir ? -64 : 64; const bool odd = (kg & 1) != 0; const int kh2 = kg >> 1;
    const LAS float* p0 = VEC + (dir ? 15 * 64 : 0) + 4 * kg;
    const LAS float* pv = VEC + 5 * 1024 + (dir ? 15 * 64 : 0) + row0;
    f32x4 w4 = *(const LAS f32x4*)p0, ka4 = *(const LAS f32x4*)(p0 + 2048), kh4 = *(const LAS f32x4*)(p0 + 3072), r4 = *(const LAS f32x4*)(p0 + 4096);
    f32x2 v2 = *(const LAS f32x2*)pv;
    f32x4 kkn = *(const LAS f32x4*)(p0 + 1024);
    float skp;
    { float d0 = S.a[0] * kkn[0], d1 = S.a[4] * kkn[0];
#pragma unroll
      for (int e = 1; e < 4; ++e) { d0 = __builtin_fmaf(S.a[e], kkn[e], d0); d1 = __builtin_fmaf(S.a[4 + e], kkn[e], d1); }
      skp = pair_red16(d0, d1, odd); }
    kkn = *(const LAS f32x4*)(p0 + sstr + 1024);
    float keepA = 0.f, keepB = 0.f;
#pragma unroll
    for (int s = 0; s < 16; ++s) {
        const LAS float* pn = p0 + (s + 1) * sstr;
        f32x4 w4n, ka4n, kh4n, r4n, kk2; f32x2 v2n;
        if (s < 15) { w4n = *(const LAS f32x4*)pn; ka4n = *(const LAS f32x4*)(pn + 2048); kh4n = *(const LAS f32x4*)(pn + 3072); if (LAT) r4n = *(const LAS f32x4*)(pn + 4096); v2n = *(const LAS f32x2*)(pv + (s + 1) * sstr); }
        if (s < 14) kk2 = *(const LAS f32x4*)(pn + sstr + 1024);
        const float sk0 = -dppmov<0xA0>(skp), sk1 = -dppmov<0xF5>(skp);
        float d0 = 0.f, d1 = 0.f, y0 = 0.f, y1 = 0.f;
#pragma unroll
        for (int e = 0; e < 4; ++e) {
            float a = opq(S.a[e] * w4[e]); a = __builtin_fmaf(ka4[e], sk0, a); a = opq(__builtin_fmaf(kh4[e], v2.x, a)); S.a[e] = a;
            float c = opq(S.a[4 + e] * w4[e]); c = __builtin_fmaf(ka4[e], sk1, c); c = opq(__builtin_fmaf(kh4[e], v2.y, c)); S.a[4 + e] = c;
            if (s < 15) { d0 = __builtin_fmaf(a, kkn[e], d0); d1 = __builtin_fmaf(c, kkn[e], d1); }
            if (LAT) { y0 = __builtin_fmaf(a, r4[e], y0); y1 = __builtin_fmaf(c, r4[e], y1); }
        }
        if (s < 15) skp = pair_red16(d0, d1, odd);
        if (LAT) { const float ty = pair_red16(y0, y1, odd);
            if ((s & 1) == 0) keepA = (kh2 == (s >> 1)) ? ty : keepA; else keepB = (kh2 == (s >> 1)) ? ty : keepB; }
        if (s < 15) { w4 = w4n; ka4 = ka4n; kh4 = kh4n; if (LAT) r4 = r4n; v2 = v2n; }
        if (s < 14) kkn = kk2;
    }
    if (LAT) { const int st = 2 * kh2; const int iA = dir ? 15 - st : st, iB = dir ? 14 - st : st + 1; const int rr = row0 + (odd ? 1 : 0);
        YB[iA * 64 + rr] = keepA; YB[iB * 64 + rr] = keepB; }
}
constexpr int CV_GU_ITEMS = NE * 2 * (D / 64) * (FF / 32);
constexpr int CV_DN_ITEMS = NE * (FF / 64) * (D / 32);
constexpr int CV_ITEMS = CV_GU_ITEMS + CV_DN_ITEMS;
#ifndef CV_SCALED_CVT
#define CV_SCALED_CVT 1
#endif
struct CvItem { const float* src; unsigned char* dst; int N; int loff; int doff; float scale; int nb, nblk, step, jump; };
__device__ __forceinline__ CvItem cv_item(Frame& F, int it, int lane) {
    const int n = lane & 31, hf = lane >> 5; CvItem c;
    if (it < CV_GU_ITEMS) { const int per_e = 2 * (D / 64) * (FF / 32); const int e = it / per_e; int r = it - e * per_e; const int up = r >= per_e / 2 ? 1 : 0; r -= up * (per_e / 2);
        const int nblk = FF / 32, kb = r / nblk, nb = r % nblk, n0 = 32 * nb, k0 = 64 * kb;
        c.src = (up ? F.in[I_EXU] : F.in[I_EXG]) + (size_t)e * D * FF + (size_t)k0 * FF + n0;
        c.dst = WSP(unsigned char, WS_WGU) + (size_t)(e * (2 * FF) + 256 * (n0 >> 7) + 128 * up + (n0 & 127)) * D + k0; c.N = FF; c.scale = W1_SCALE;
        c.loff = 32 * hf * FF + n; c.doff = n * D + 32 * hf; c.nb = nb; c.nblk = nblk; c.step = 32 * D; c.jump = 128 * D;
    } else { int r = it - CV_GU_ITEMS; const int per_e = (FF / 64) * (D / 32); const int e = r / per_e; r -= e * per_e; const int nblk = D / 32, kb = r / nblk, nb = r % nblk, n0 = 32 * nb, k0 = 64 * kb;
        c.src = F.in[I_EXD] + (size_t)e * FF * D + (size_t)k0 * D + n0;
        c.dst = WSP(unsigned char, WS_WD) + (size_t)(e * D + n0) * FF + k0; c.N = D; c.scale = W2_SCALE;
        c.loff = 32 * hf * D + n; c.doff = n * FF + 32 * hf; c.nb = nb; c.nblk = nblk; c.step = 32 * FF; c.jump = 0; }
    return c;
}
__device__ __forceinline__ void cv_item_next(Frame& F, CvItem& c, int it, int lane) {
    const int nb = c.nb + 1;
    if (nb == c.nblk) { c = cv_item(F, it, lane); return; }
    c.nb = nb; c.src += 32; c.dst += c.step + ((nb & 3) == 0 ? c.jump : 0);
}
struct CvRegs { float v[32]; };
__device__ __forceinline__ void cv_issue(const CvItem& c, CvRegs& R) {
    const char* base = (const char*)c.src; const unsigned offb = (unsigned)c.loff * 4u;
#pragma unroll
    for (int i = 0; i < 32; ++i) { R.v[i] = __builtin_nontemporal_load((const float*)(base + offb)); base += (size_t)c.N * 4; }
}
typedef short cv_s2 __attribute__((ext_vector_type(2)));
__device__ __forceinline__ unsigned pk4_fp8_scaled(float a, float b, float c_, float d, float inv_scale) {
    cv_s2 r = {0, 0}; r = __builtin_amdgcn_cvt_scalef32_pk_fp8_f32(r, a, b, inv_scale, false); r = __builtin_amdgcn_cvt_scalef32_pk_fp8_f32(r, c_, d, inv_scale, true);
    return __builtin_bit_cast(unsigned, r); }
__device__ __forceinline__ void cv_finish(const CvItem& c, const CvRegs& R) {
    v4u* d = (v4u*)(c.dst + c.doff); const float inv = 1.0f / c.scale;
#pragma unroll
    for (int q = 0; q < 2; ++q) { unsigned w[4];
#pragma unroll
        for (int u = 0; u < 4; ++u) { const int i = 16 * q + 4 * u;
#if CV_SCALED_CVT
            w[u] = pk4_fp8_scaled(R.v[i], R.v[i + 1], R.v[i + 2], R.v[i + 3], inv);
#else
            w[u] = pk4_fp8(R.v[i] * c.scale, R.v[i + 1] * c.scale, R.v[i + 2] * c.scale, R.v[i + 3] * c.scale);
#endif
        }
        d[q] = (v4u){w[0], w[1], w[2], w[3]}; }
}
constexpr int VP = 66;
template <int N> __device__ __forceinline__ float dpp_shr(float v) { return __builtin_bit_cast(float, __builtin_amdgcn_update_dpp(0, __builtin_bit_cast(int, v), 0x110 + N, 0xF, 0xF, true)); }
__device__ __forceinline__ float row_prefix16(float x) { x += dpp_shr<1>(x); x += dpp_shr<2>(x); x += dpp_shr<4>(x); x += dpp_shr<8>(x); return x; }
__device__ __forceinline__ float rowpair_sum(float x) {
    const int xi = __builtin_bit_cast(int, x); const auto r = __builtin_amdgcn_permlane16_swap(xi, xi, false, false); const int r0 = r[0], r1 = r[1];
    return __builtin_bit_cast(float, r0) + __builtin_bit_cast(float, r1); }
__device__ __forceinline__ float row_total16(float x) { x += dppmov<0xB1>(x); x += dppmov<0x4E>(x); x += dppmov<0x124>(x); x += dppmov<0x128>(x); return x; }
#ifndef PROBE_SCAN
#define PROBE_SCAN 0
#endif
#ifndef SCAN_B2B_IN_J2
#define SCAN_B2B_IN_J2 0
#endif
#ifndef SJ_W13
#define SJ_W13 1
#endif
#ifndef SJ_ISSUE_IN_J1
#define SJ_ISSUE_IN_J1 0
#endif
#ifndef SOLVER_GROUPED
#define SOLVER_GROUPED 1
#endif
__device__ __forceinline__ void scan_unit(Frame& F, int unit) {
    const int b = unit >> 4, h = (unit >> 1) & 7, dir = unit & 1;
    LAS float* ZS = (LAS float*)F.lds;
    LAS float* TWLA = ZS + 16 * 192;
    LAS float* VV = TWLA + 2 * 16 * 64;
    LAS float* YB = VV + 6 * 16 * VP;
    LAS float* PRM = YB + 16 * 64;
    LAS float* GL2 = PRM + 5 * 64;
    LAS float* MF2 = GL2 + 2 * 64;
    LAS float* RHS = MF2 + 2 * 256;
    LAS bf16* AL = (LAS bf16*)(RHS + 16 * 68);
    LAS bf16* W2T = AL + 16 * SC_ALD;
    LAS bf16* A2T = W2T + 64 * SC_WLD;
    LAS bf16* A12 = A2T + 64 * SC_WLD;
    LAS bf16* B1 = A12 + 2 * 32 * 72;
    LAS bf16* KCT2 = B1 + 32 * 72;
    LAS bf16* EV2 = KCT2 + 2 * 64 * 40;
    LAS bf16* MKI = EV2 + 2 * 64 * 40;
    LAS bf16* AY2 = MKI + 16 * 40;
    LAS bf16* SB = AY2 + 2 * 16 * 40;
    const bf16* Z = WSP(bf16, WS_Z);
    bf16* Y = (bf16*)F.out; float* CB = WSP(float, WS_CB);
    const int tid = F.tid, lane = F.lane, wv = F.wave, fr = lane & 15, fq = lane >> 4;
    __syncthreads();
    { float w2v[4], a2v[4];
#pragma unroll
      for (int q = 0; q < 4; ++q) { const int i = tid + NTHR * q, j = i >> 6, c = i & 63; w2v[q] = F.in[I_W2][(size_t)(dir * 32 + j) * 512 + h * 64 + c]; a2v[q] = F.in[I_A2][(size_t)(dir * 32 + j) * 512 + h * 64 + c]; }
#pragma unroll
      for (int q = 0; q < 4; ++q) { const int i = tid + NTHR * q, j = i >> 6, c = i & 63; W2T[c * SC_WLD + j] = (bf16)f2bf(w2v[q]); A2T[c * SC_WLD + j] = (bf16)f2bf(a2v[q]); } }
    if (tid < 64) { PRM[tid] = F.in[I_W0][dir * 512 + h * 64 + tid]; PRM[64 + tid] = F.in[I_A0][dir * 512 + h * 64 + tid];
        PRM[128 + tid] = F.in[I_KK][h * 64 + tid]; PRM[192 + tid] = F.in[I_KA][h * 64 + tid]; PRM[256 + tid] = F.in[I_RK][h * 64 + tid]; }
    for (int i = tid; i < 64 * 72; i += NTHR) SB[i] = 0;
    for (int i = tid; i < 2 * 64 * 40; i += NTHR) EV2[i] = 0;
    for (int i = tid; i < 16 * 40; i += NTHR) MKI[i] = 0;
    int ia, cg;
    if (wv < 6) { const int id = wv * 64 + lane; ia = id / 24; cg = id - 24 * ia; } else { ia = lane >> 2; cg = (wv == 6 ? 24 : 28) + (lane & 3); }
    int zcol;
    if (cg < 8) zcol = C_R + 64 * h + 8 * cg; else if (cg < 16) zcol = C_K + 64 * h + 8 * (cg - 8); else if (cg < 24) zcol = C_V + 64 * h + 8 * (cg - 16);
    else if (cg < 28) zcol = (dir ? C_WDB : C_WDF) + 8 * (cg - 24); else zcol = (dir ? C_ADB : C_ADF) + 8 * (cg - 28);
    float mu8[8];
#pragma unroll
    for (int e = 0; e < 8; ++e) mu8[e] = F.in[I_MU][zcol - (cg < 8 ? 0 : MU_SHIFT) + e];
    f32x4 Sacc[2] = {{0.f, 0.f, 0.f, 0.f}, {0.f, 0.f, 0.f, 0.f}};
    v4u pc, pn[4];
#define SCAN_GEOM(n_) const int k_ = (n_); const bool lat_ = k_ >= 16; const int li_ = dir ? 127 - (k_ - 16) : k_ - 16, ci_ = dir ? 15 - k_ : k_; \
        const int row0_ = lat_ ? zrow_lat(b, 16 * li_) : zrow_ctx(b, 16 * ci_), spos_ = lat_ ? 16 * (li_ & 3) : 16 * ci_, last_ = lat_ ? 63 : TC - 1; \
        const bool up_ = lat_ && (li_ >> 2) > 0, dn_ = lat_ && (li_ >> 2) < 31; const bool lf_ = spos_ + ia > 0, rt_ = spos_ + ia < last_
#define SCAN_ISSUE(n_) do { SCAN_GEOM(n_); const bf16* pz_ = Z + (size_t)(row0_ + ia) * INW + zcol; pc = *(const v4u*)pz_; \
        pn[0] = *(const v4u*)(pz_ - (lf_ ? INW : 0)); pn[1] = *(const v4u*)(pz_ + (rt_ ? INW : 0)); pn[2] = *(const v4u*)(pz_ - (up_ ? 64 * INW : 0)); pn[3] = *(const v4u*)(pz_ + (dn_ ? 64 * INW : 0)); } while (0)
#define ST_A(n_) do { float zs[8]; { SCAN_GEOM(n_); Nbr nb_; nb_.m[0] = lf_ ? 1.f : 0.f; nb_.m[1] = rt_ ? 1.f : 0.f; nb_.m[2] = up_ ? 1.f : 0.f; nb_.m[3] = dn_ ? 1.f : 0.f; nb_.coef = lat_ ? 0.25f : 0.5f; \
          shift8(pc, pn, nb_, mu8, zs); } \
        if (wv < 6) { *(LAS f32x4*)(ZS + ia * 192 + cg * 8) = (f32x4){zs[0], zs[1], zs[2], zs[3]}; *(LAS f32x4*)(ZS + ia * 192 + cg * 8 + 4) = (f32x4){zs[4], zs[5], zs[6], zs[7]}; } \
        else { if (wv == 6) { _Pragma("unroll") for (int e = 0; e < 8; ++e) zs[e] = 1.0f - 2.0f * __builtin_amdgcn_rcpf(1.0f + __builtin_amdgcn_exp2f(zs[e] * 2.88539008177793f)); } \
            *(LAS v4u*)(AL + ia * SC_ALD + (cg - 24) * 8) = (v4u){pk2(zs[0], zs[1]), pk2(zs[2], zs[3]), pk2(zs[4], zs[5]), pk2(zs[6], zs[7])}; } } while (0)
#define ST_B1_TILE(which_, nt_) do { const int which = (which_), nt = (nt_); \
        const bf16x8 af = *(const LAS bf16x8*)(AL + fr * SC_ALD + 32 * which + 8 * fq); \
        const bf16x8 bfr = *(const LAS bf16x8*)((which ? A2T : W2T) + (16 * nt + fr) * SC_WLD + 8 * fq); \
        const f32x4 acc = __builtin_amdgcn_mfma_f32_16x16x32_bf16(af, bfr, (f32x4){0.f, 0.f, 0.f, 0.f}, 0, 0, 0); \
        _Pragma("unroll") for (int r = 0; r < 4; ++r) TWLA[(which * 16 + 4 * fq + r) * 64 + 16 * nt + fr] = acc[r]; } while (0)
#define ST_B1() do { if (wv != 0) { ST_B1_TILE(wv >> 2, wv & 3); if (wv == 1) ST_B1_TILE(0, 0); } } while (0)
#define ST_B2A(m_) do { const int ib = tid >> 5, c2 = (tid & 31) * 2, sp = dir ? 15 - ib : ib; \
        const f32x2 tw = *(const LAS f32x2*)(TWLA + ib * 64 + c2), la = *(const LAS f32x2*)(TWLA + (16 + ib) * 64 + c2); \
        const f32x2 zr = *(const LAS f32x2*)(ZS + ib * 192 + c2), zk = *(const LAS f32x2*)(ZS + ib * 192 + 64 + c2), zv = *(const LAS f32x2*)(ZS + ib * 192 + 128 + c2); \
        const f32x2 w0 = *(const LAS f32x2*)(PRM + c2), a0 = *(const LAS f32x2*)(PRM + 64 + c2), pkk = *(const LAS f32x2*)(PRM + 128 + c2), pka = *(const LAS f32x2*)(PRM + 192 + c2), prk = *(const LAS f32x2*)(PRM + 256 + c2); \
        float dd[2], aa[2], kh[2], kkr[2]; float ss = 0.f, cbp = 0.f; \
        _Pragma("unroll") for (int q = 0; q < 2; ++q) { \
            dd[q] = 0.60653065971263342f * fsigmoid(w0[q] + tw[q]); aa[q] = fsigmoid(a0[q] + la[q]); \
            kh[q] = zk[q] * (1.0f + (aa[q] - 1.0f) * pka[q]); kkr[q] = zk[q] * pkk[q]; \
            ss += kkr[q] * kkr[q]; cbp += zr[q] * kh[q] * prk[q]; } \
        ss = red16(ss); cbp = red16(cbp); ss = rowpair_sum(ss); cbp = rowpair_sum(cbp); \
        const float rn = __builtin_amdgcn_rsqf(ss + 1e-12f); \
        *(LAS f32x2*)(VV + (0 * 16 + sp) * VP + c2) = (f32x2){dd[0], dd[1]}; \
        *(LAS f32x2*)(VV + (1 * 16 + sp) * VP + c2) = (f32x2){kkr[0] * rn, kkr[1] * rn}; \
        *(LAS f32x2*)(VV + (2 * 16 + sp) * VP + c2) = (f32x2){kkr[0] * rn * aa[0], kkr[1] * rn * aa[1]}; \
        *(LAS f32x2*)(VV + (3 * 16 + sp) * VP + c2) = (f32x2){kh[0], kh[1]}; \
        *(LAS f32x2*)(VV + (4 * 16 + sp) * VP + c2) = zr; \
        *(LAS f32x2*)(VV + (5 * 16 + sp) * VP + c2) = zv; \
        if ((m_) >= 16 && (m_) < 144 && (tid & 31) == 0) CB[((size_t)dir * M_LAT + scan_base_row(m_, dir, b) + ib) * 8 + h] = cbp; } while (0)
#define ST_B2B(par_) do { const int sp = tid & 15, c2 = (tid >> 4) * 2; LAS bf16* A1p = A12 + (par_) * 32 * 72; LAS bf16* KCTp = KCT2 + (par_) * 64 * 40; LAS bf16* EVp = EV2 + (par_) * 64 * 40; \
        const f32x2 dd = *(const LAS f32x2*)(VV + (0 * 16 + sp) * VP + c2), kkn = *(const LAS f32x2*)(VV + (1 * 16 + sp) * VP + c2), kka = *(const LAS f32x2*)(VV + (2 * 16 + sp) * VP + c2), \
                    khv = *(const LAS f32x2*)(VV + (3 * 16 + sp) * VP + c2), rv = *(const LAS f32x2*)(VV + (4 * 16 + sp) * VP + c2), vv = *(const LAS f32x2*)(VV + (5 * 16 + sp) * VP + c2); \
        float okk[2], orr[2], oka[2], okh[2], ohc[2], oac[2]; \
        _Pragma("unroll") for (int q = 0; q < 2; ++q) { const float cum = row_prefix16(dd[q]); \
            const float g = fexp(-cum), gi = __builtin_amdgcn_rcpf(g), g15 = dppmov<0x15F>(g), glg = g15 * gi;     \
            const float gm1 = __builtin_bit_cast(float, __builtin_amdgcn_update_dpp(0x3f800000, __builtin_bit_cast(int, g), 0x111, 0xF, 0xF, false)); \
            okk[q] = kkn[q] * gm1; orr[q] = rv[q] * g; oka[q] = kka[q] * gi; okh[q] = khv[q] * gi; ohc[q] = khv[q] * glg; oac[q] = -(kka[q] * glg); \
            if (sp == 15) GL2[(par_) * 64 + c2 + q] = g; } \
        *(LAS unsigned*)(A1p + sp * 72 + c2) = pk2(okk[0], okk[1]); *(LAS unsigned*)(A1p + (16 + sp) * 72 + c2) = pk2(orr[0], orr[1]); \
        *(LAS unsigned*)(B1 + sp * 72 + c2) = pk2(oka[0], oka[1]); *(LAS unsigned*)(B1 + (16 + sp) * 72 + c2) = pk2(okh[0], okh[1]); \
        KCTp[c2 * 40 + sp] = (bf16)f2bf(ohc[0]); KCTp[(c2 + 1) * 40 + sp] = (bf16)f2bf(ohc[1]); \
        KCTp[c2 * 40 + 16 + sp] = (bf16)f2bf(oac[0]); KCTp[(c2 + 1) * 40 + 16 + sp] = (bf16)f2bf(oac[1]); \
        EVp[c2 * 40 + sp] = (bf16)f2bf(vv[0]); EVp[(c2 + 1) * 40 + sp] = (bf16)f2bf(vv[1]); } while (0)
#define ST_G(par_, gw0_) do { if (wv >= (gw0_) && wv < (gw0_) + 4) { const int rs = (wv - (gw0_)) >> 1, cj = (wv - (gw0_)) & 1; f32x4 acc = {0.f, 0.f, 0.f, 0.f}; const LAS bf16* A1p = A12 + (par_) * 32 * 72; \
        _Pragma("unroll") for (int ks = 0; ks < 2; ++ks) acc = __builtin_amdgcn_mfma_f32_16x16x32_bf16(*(const LAS bf16x8*)(A1p + (16 * rs + fr) * 72 + 32 * ks + 8 * fq), *(const LAS bf16x8*)(B1 + (16 * cj + fr) * 72 + 32 * ks + 8 * fq), acc, 0, 0, 0); \
        const int jlim_ = fr - rs;                                     \
        if (rs == 0 && cj == 0) { _Pragma("unroll") for (int r = 0; r < 4; ++r) { const int srow = 4 * fq + r; MF2[(par_) * 256 + srow * 16 + fr] = (fr < srow) ? acc[r] : 0.f; } } \
        else { LAS bf16* gd_ = rs == 0 ? MKI + fr : AY2 + (par_) * 16 * 40 + (cj ? 0 : 16) + fr; const float sg_ = (rs == 1 && cj == 0) ? -1.0f : 1.0f; \
            _Pragma("unroll") for (int r = 0; r < 4; ++r) { const int srow = 4 * fq + r; gd_[srow * 40] = (bf16)f2bf((jlim_ < srow) ? acc[r] * sg_ : 0.f); } } } } while (0)
    CvRegs cvr; CvItem cvi; cvi.src = nullptr; cvi.dst = nullptr; cvi.N = 0; cvi.loff = 0; cvi.doff = 0; cvi.scale = 0.f; cvi.nb = 0; cvi.nblk = 0; cvi.step = 0; cvi.jump = 0;
    bool cv_pending = false;
    SCAN_ISSUE(0);
    ST_A(0); SCAN_ISSUE(1); __syncthreads();
    ST_B1(); __syncthreads();
    ST_B2A(0); __syncthreads();
    ST_B2B(0); ST_A(1); SCAN_ISSUE(2); __syncthreads();
    ST_G(0, 4); ST_B1(); __syncthreads();
    ST_B2A(1); __syncthreads();
    for (int n = 0; n < 144; ++n) {
        const bool is_lat = n >= 16; const int par = n & 1, qar = par ^ 1;
        LAS bf16* A1p = A12 + par * 32 * 72; LAS bf16* EVp = EV2 + par * 64 * 40; LAS bf16* KCTp = KCT2 + par * 64 * 40;
        if (n >= 17) { const int iy = tid >> 5, v2i = (tid & 31) * 2; const f32x2 yv = *(const LAS f32x2*)(YB + iy * 64 + v2i);
            *(unsigned*)(Y + ((size_t)dir * M_LAT + scan_base_row(n - 1, dir, b) + iy) * 512 + h * 64 + v2i) = pk2(yv.x, yv.y); }
#if PROBE_SCAN == 11
        __builtin_amdgcn_s_sleep(16);
#endif
        f32x4 acc1 = {0.f, 0.f, 0.f, 0.f};
        { const int vi = wv & 3, which = wv >> 2;
          if (which == 0 || is_lat) {
#pragma unroll
              for (int ks = 0; ks < 2; ++ks) acc1 = __builtin_amdgcn_mfma_f32_16x16x32_bf16(*(const LAS bf16x8*)(A1p + (16 * which + fr) * 72 + 32 * ks + 8 * fq), *(const LAS bf16x8*)(SB + (16 * vi + fr) * 72 + 32 * ks + 8 * fq), acc1, 0, 0, 0); }
          if (which == 0) { acc1 = __builtin_amdgcn_mfma_f32_16x16x32_bf16(*(const LAS bf16x8*)(MKI + fr * 40 + 8 * fq), *(const LAS bf16x8*)(EVp + (16 * vi + fr) * 40 + 8 * fq), acc1, 0, 0, 0);
#pragma unroll
              for (int r = 0; r < 4; ++r) RHS[(4 * fq + r) * 68 + 16 * vi + fr] = acc1[r]; } }
        ST_A(n + 2 < 144 ? n + 2 : 143);
#if SIDEJOB == 1 && SJ_ISSUE_IN_J1
        if (wv != 0) { const int ph = n - (wv % 3);
            if (ph >= 0) { const int q = ph / 3, pm = ph - 3 * q, li = (wv - 1) + 7 * q;
                if (pm == 0 && li < 264) { cvi = cv_item(F, unit * 264 + li, lane); cv_issue(cvi, cvr); cv_pending = true; } } }
#endif
        SCAN_ISSUE(n + 3 < 144 ? n + 3 : 143);
#if !SCAN_B2B_IN_J2
        ST_B2B(qar);
#endif
        __syncthreads();
#if PROBE_SCAN == 5
        __syncthreads();
#endif
#if PROBE_SCAN == 12
        __builtin_amdgcn_s_sleep(16);
#endif
        { int lane_o_ = F.lane; asm volatile("" : "+v"(lane_o_));
          const int lane = lane_o_, fr = lane_o_ & 15, fq = lane_o_ >> 4;
        ST_B1();
#if SCAN_B2B_IN_J2
        ST_B2B(qar);
#else
        ST_G(qar, 4);
#endif
#if SJ_W13
        if (SIDEJOB == 1 && wv >= 1 && wv <= 3) {
            const int it = unit * 264 + (wv - 1) * 88 + n;
            if (cv_pending) { cv_finish(cvi, cvr); cv_pending = false; }
            if (n < 88) { if (n == 0) cvi = cv_item(F, it, lane); else cv_item_next(F, cvi, it, lane); cv_issue(cvi, cvr); cv_pending = true; } }
#else
        if (SIDEJOB == 1 && wv != 0) {
            const int ph = n - (wv % 3);
            if (ph >= 0) { const int q = ph / 3, pm = ph - 3 * q, li = (wv - 1) + 7 * q;
                if (!SJ_ISSUE_IN_J1 && pm == 0 && li < 264) { cvi = cv_item(F, unit * 264 + li, lane); cv_issue(cvi, cvr); cv_pending = true; }
                if (pm == 1 && cv_pending) { cv_finish(cvi, cvr); cv_pending = false; } } }
#endif
#if PROBE_SCAN == 1
        for (int rep_ = 0; rep_ < 2; ++rep_)
#endif
        if (wv == 0) { float e[16], rh[16]; const LAS float* MFp = MF2 + par * 256;
#if SOLVER_GROUPED
            f32x4 bk0[8], bk1[8];
#define SV_LD(bk_, o_, s_, nb_) do { _Pragma("unroll") for (int q_ = 0; q_ < (nb_); ++q_) bk_[(o_) + q_] = *(const LAS f32x4*)(MFp + (s_) * 16 + 4 * q_); } while (0)
#define SV_ROW(bk_, o_, s_) do { float a_ = rh[s_]; _Pragma("unroll") for (int j_ = 0; j_ < (s_); ++j_) a_ = __builtin_fmaf(-bk_[(o_) + (j_ >> 2)][j_ & 3], e[j_], a_); e[s_] = opq(a_); } while (0)
            SV_LD(bk0, 0, 1, 1); SV_LD(bk0, 1, 2, 1); SV_LD(bk0, 2, 3, 1); SV_LD(bk0, 3, 4, 1); SV_LD(bk0, 4, 5, 2); SV_LD(bk0, 6, 6, 2);
#pragma unroll
            for (int s2 = 0; s2 < 16; ++s2) rh[s2] = RHS[s2 * 68 + lane];
            SV_LD(bk1, 0, 7, 2); SV_LD(bk1, 2, 8, 2); SV_LD(bk1, 4, 9, 3);
            __builtin_amdgcn_sched_barrier(0);
            e[0] = rh[0];
            SV_ROW(bk0, 0, 1); SV_ROW(bk0, 1, 2); SV_ROW(bk0, 2, 3); SV_ROW(bk0, 3, 4); SV_ROW(bk0, 4, 5); SV_ROW(bk0, 6, 6);
            __builtin_amdgcn_sched_barrier(0);
            SV_LD(bk0, 0, 10, 3); SV_LD(bk0, 3, 11, 3);
            __builtin_amdgcn_sched_barrier(0);
            SV_ROW(bk1, 0, 7); SV_ROW(bk1, 2, 8); SV_ROW(bk1, 4, 9);
            __builtin_amdgcn_sched_barrier(0);
            SV_LD(bk1, 0, 12, 3); SV_LD(bk1, 3, 13, 4);
            __builtin_amdgcn_sched_barrier(0);
            SV_ROW(bk0, 0, 10); SV_ROW(bk0, 3, 11);
            __builtin_amdgcn_sched_barrier(0);
            SV_LD(bk0, 0, 14, 4); SV_LD(bk0, 4, 15, 4);
            __builtin_amdgcn_sched_barrier(0);
            SV_ROW(bk1, 0, 12); SV_ROW(bk1, 3, 13);
            __builtin_amdgcn_sched_barrier(0);
            SV_ROW(bk0, 0, 14); SV_ROW(bk0, 4, 15);
#undef SV_LD
#undef SV_ROW
#else
#pragma unroll
            for (int s2 = 0; s2 < 16; ++s2) rh[s2] = RHS[s2 * 68 + lane];
#pragma unroll
            for (int s2 = 0; s2 < 16; ++s2) { float a = rh[s2];
#pragma unroll
                for (int j4 = 0; j4 < (s2 + 3) / 4; ++j4) { const f32x4 m4 = *(const LAS f32x4*)(MFp + s2 * 16 + 4 * j4);
#pragma unroll
                    for (int q = 0; q < 4; ++q) if (4 * j4 + q < s2) a = __builtin_fmaf(-m4[q], e[4 * j4 + q], a); }
                e[s2] = opq(a); asm volatile("" ::: "memory"); }
#endif
            *(LAS v4u*)(EVp + lane * 40 + 16) = (v4u){pk2(e[0], e[1]), pk2(e[2], e[3]), pk2(e[4], e[5]), pk2(e[6], e[7])};
            *(LAS v4u*)(EVp + lane * 40 + 24) = (v4u){pk2(e[8], e[9]), pk2(e[10], e[11]), pk2(e[12], e[13]), pk2(e[14], e[15])}; }
        }
#if PROBE_SCAN == 6
        if (wv == 0) __builtin_amdgcn_s_sleep(8);
#endif
#if PROBE_SCAN == 7
        if (wv != 0) __builtin_amdgcn_s_sleep(8);
#endif
#if PROBE_SCAN == 8
        __builtin_amdgcn_s_sleep(8);
#endif
        __syncthreads();
#if PROBE_SCAN == 5
        __syncthreads();
#endif
        if (wv >= 4 && is_lat) { const int vi = wv & 3;
            acc1 = __builtin_amdgcn_mfma_f32_16x16x32_bf16(*(const LAS bf16x8*)(AY2 + par * 16 * 40 + fr * 40 + 8 * fq), *(const LAS bf16x8*)(EVp + (16 * vi + fr) * 40 + 8 * fq), acc1, 0, 0, 0);
#pragma unroll
            for (int r = 0; r < 4; ++r) { const int sp = 4 * fq + r, it = dir ? 15 - sp : sp; YB[it * 64 + 16 * vi + fr] = acc1[r]; } }
#pragma unroll
        for (int t = 0; t < 2; ++t) { const int tl = 2 * wv + t, vi = tl >> 2, ki = tl & 3;
            f32x4 acc = Sacc[t] * GL2[par * 64 + 16 * ki + fr];
            acc = __builtin_amdgcn_mfma_f32_16x16x32_bf16(*(const LAS bf16x8*)(EVp + (16 * vi + fr) * 40 + 8 * fq), *(const LAS bf16x8*)(KCTp + (16 * ki + fr) * 40 + 8 * fq), acc, 0, 0, 0);
            Sacc[t] = acc;
#pragma unroll
            for (int r = 0; r < 4; ++r) SB[(16 * vi + 4 * fq + r) * 72 + 16 * ki + fr] = (bf16)f2bf(acc[r]); }
#if PROBE_SCAN == 13
        __builtin_amdgcn_s_sleep(16);
#endif
        ST_B2A(n + 2);
#if SCAN_B2B_IN_J2
        ST_G(qar, 0);
#endif
        __syncthreads();
#if PROBE_SCAN == 5
        __syncthreads();
#endif
    }
    { const int iy = tid >> 5, v2i = (tid & 31) * 2; const f32x2 yv = *(const LAS f32x2*)(YB + iy * 64 + v2i);
      *(unsigned*)(Y + ((size_t)dir * M_LAT + scan_base_row(143, dir, b) + iy) * 512 + h * 64 + v2i) = pk2(yv.x, yv.y); }
    if (SIDEJOB == 1 && cv_pending) cv_finish(cvi, cvr);
#undef SCAN_ISSUE
#undef ST_A
#undef ST_B1
#undef ST_B1_TILE
#undef SCAN_GEOM
#undef ST_B2A
#undef ST_B2B
#undef ST_G
    __syncthreads();
}

constexpr int GLD = 72;
__device__ __forceinline__ bf16x8 lds_frag(const LAS bf16* img, int row, int k0) { return *(const LAS bf16x8*)(img + row * GLD + k0); }
__device__ __forceinline__ float flog(float x) { return __builtin_amdgcn_logf(x) * 0.69314718055994531f; }
constexpr int LAFLD = 68;
__device__ __forceinline__ void gla_unit(Frame& F, int unit) {
    const int b = unit >> 4, g = (unit >> 2) & 3, dir = (unit >> 1) & 1, vh = unit & 1;
    LAS bf16* QI = (LAS bf16*)F.lds; LAS bf16* KI = QI + 64 * GLD; LAS bf16* KOT = KI + 64 * GLD; LAS bf16* VT = KOT + 64 * GLD; LAS bf16* SC = VT + 64 * GLD; LAS bf16* ST = SC + 64 * GLD;
    LAS bf16* RQ = ST + 64 * GLD; LAS bf16* RK = RQ + 64 * GLD; LAS bf16* RV = RK + 64 * GLD;
    LAS bf16* OT = RV + 64 * GLD;
    LAS bf16* GADB = OT + 64 * GLD;
    LAS bf16* A2T = GADB + 64 * 40;
    LAS float* LAF = (LAS float*)(A2T + 64 * 40);
    LAS float* BL = LAF + 64 * LAFLD;
    LAS float* PART = BL + 64;
    const bf16* Z = WSP(bf16, WS_Z); bf16* O = WSP(bf16, WS_O);
    const int tid = F.tid, lane = F.lane, wv = F.wave, c = tid & 63, pg = wv;
    const int fr = lane & 15, fq = lane >> 4;
    const int pl = tid >> 3, g8 = tid & 7;
    const float ab2 = F.in[I_GLAB][dir * 256 + 64 * g + c] * 1.44269504088896f;
    const int cgad = dir ? C_GADB : C_GADF;
    __syncthreads();
    for (int i = tid; i < 64 * GLD; i += NTHR) ST[i] = 0;
#pragma unroll
    for (int q = 0; q < 5; ++q) { const int i = tid + NTHR * q; GADB[i] = 0; const int cc = i / 40, j = i % 40;
        const float a2v = F.in[I_GLA2][(size_t)(dir * 16 + (j < 16 ? j : 15)) * 256 + 64 * g + cc]; A2T[i] = j < 16 ? (bf16)f2bf(a2v) : (bf16)0; }
    f32x4 Sacc[2] = {{0.f, 0.f, 0.f, 0.f}, {0.f, 0.f, 0.f, 0.f}};
    const int tl0 = 2 * wv;
    const int pa = 16 * (wv >> 1) + fr;
    v4u rq, rk, rv, ra;
#define GLA_BASE(n_) ((n_) < 4 ? zrow_ctx(b, 64 * (dir ? 3 - (n_) : (n_))) : zrow_lat(b, 64 * (dir ? 31 - ((n_) - 4) : ((n_) - 4))))
#define GLA_ISSUE(n_) do { const bf16* zr_ = Z + (size_t)(GLA_BASE(n_) + (dir ? 63 - pl : pl)) * INW; \
        rq = *(const v4u*)(zr_ + C_Q + 64 * g + 8 * g8); rk = *(const v4u*)(zr_ + C_KG + 64 * g + 8 * g8); rv = *(const v4u*)(zr_ + C_VG + 128 * g + 64 * vh + 8 * g8); \
        ra = *(const v4u*)(Z + (size_t)(GLA_BASE(n_) + (dir ? 63 - pa : pa)) * INW + cgad + 8 * (fq & 1)); } while (0)
    GLA_ISSUE(0);
    __syncthreads();
#ifndef PROBE_GLA
#define PROBE_GLA 0
#endif
    unsigned long long gp_sum = 0, gp_last = 0;
#define GP_T(k) do { if (PROBE_GLA != 0) { const unsigned long long now_ = __builtin_readcyclecounter(); if ((k) != 0 && (PROBE_GLA == (k) || (PROBE_GLA == 56 && (k) == 6) || (PROBE_GLA == 12 && ((k) == 1 || (k) == 2)))) gp_sum += now_ - gp_last; gp_last = now_; } } while (0)
    for (int n = 0; n < 36; ++n) { GP_T(0);
        const bool is_lat = n >= 4; const int base = GLA_BASE(n);
        *(LAS v4u*)(RQ + pl * GLD + 8 * g8) = rq; *(LAS v4u*)(RK + pl * GLD + 8 * g8) = rk; *(LAS v4u*)(RV + pl * GLD + 8 * g8) = rv;
        { const v4u az = fq < 2 ? ra : (v4u){0u, 0u, 0u, 0u}; const bf16x8 af = __builtin_bit_cast(bf16x8, az);
#pragma unroll
          for (int t = 0; t < 2; ++t) { const int tl = tl0 + t, pi = tl >> 2, ci = tl & 3;
            const f32x4 acc = __builtin_amdgcn_mfma_f32_16x16x32_bf16(af, *(const LAS bf16x8*)(A2T + (16 * ci + fr) * 40 + 8 * fq), (f32x4){0.f, 0.f, 0.f, 0.f}, 0, 0, 0);
#pragma unroll
            for (int r = 0; r < 4; ++r) LAF[(16 * pi + 4 * fq + r) * LAFLD + 16 * ci + fr] = acc[r]; } }
        GLA_ISSUE(n + 1 < 36 ? n + 1 : 35);
        __syncthreads(); GP_T(1);
        { unsigned vtw[4];
#pragma unroll
          for (int e = 0; e < 4; ++e) vtw[e] = (unsigned)RV[(8 * pg + 2 * e) * GLD + c] | ((unsigned)RV[(8 * pg + 2 * e + 1) * GLD + c] << 16);
          *(LAS v4u*)(VT + c * GLD + 8 * pg) = (v4u){vtw[0], vtw[1], vtw[2], vtw[3]}; }
        GP_T(2);
        float cs[8]; float run = 0.f;
#pragma unroll
        for (int e = 0; e < 8; ++e) { const float sg2 = __builtin_fmaf(LAF[(8 * pg + e) * LAFLD + c], 1.44269504088896f, ab2);
            run = __builtin_fmaf(__builtin_amdgcn_logf(1.0f + __builtin_amdgcn_exp2f(-sg2)), -1.0f / 16.0f, run); cs[e] = run; }
        PART[pg * 64 + c] = run;
        __syncthreads(); GP_T(3);
        float pre = 0.f, tot = 0.f;
#pragma unroll
        for (int w = 0; w < 8; ++w) { const float pv = PART[w * 64 + c]; tot += pv; pre = __builtin_fmaf(pv, w < pg ? 1.0f : 0.0f, pre); }
        const float etot = __builtin_amdgcn_exp2f(tot);
        unsigned kow[4];
#pragma unroll
        for (int e = 0; e < 8; e += 2) {
            float ko[2];
#pragma unroll
            for (int u = 0; u < 2; ++u) { const float qv = bf1(RQ[(8 * pg + e + u) * GLD + c]), kv = bf1(RK[(8 * pg + e + u) * GLD + c]);
                const float bb = pre + cs[e + u]; const float eb = __builtin_amdgcn_exp2f(bb), ieb = __builtin_amdgcn_exp2f(-bb); const float qi = qv * eb, ki = kv * ieb; ko[u] = ki * etot;
                QI[(8 * pg + e + u) * GLD + c] = (bf16)f2bf(qi); KI[(8 * pg + e + u) * GLD + c] = (bf16)f2bf(ki); }
            kow[e >> 1] = pk2(ko[0], ko[1]); }
        *(LAS v4u*)(KOT + c * GLD + 8 * pg) = (v4u){kow[0], kow[1], kow[2], kow[3]};
        if (pg == 0) BL[c] = etot;
        __syncthreads(); GP_T(4);
        if (is_lat) {
#pragma unroll
            for (int t = 0; t < 2; ++t) { const int tl = tl0 + t, mi = tl >> 2, ni = tl & 3; f32x4 acc = {0.f, 0.f, 0.f, 0.f};
                if (ni <= mi) {
#pragma unroll
                    for (int ks = 0; ks < 2; ++ks) acc = __builtin_amdgcn_mfma_f32_16x16x32_bf16(lds_frag(QI, 16 * mi + fr, 32 * ks + 8 * fq), lds_frag(KI, 16 * ni + fr, 32 * ks + 8 * fq), acc, 0, 0, 0); }
#pragma unroll
                for (int r = 0; r < 4; ++r) { const int p = 16 * mi + 4 * fq + r, j = 16 * ni + fr; SC[p * GLD + j] = (bf16)f2bf(j <= p ? acc[r] : 0.f); } }
            __syncthreads();
#pragma unroll
            for (int t = 0; t < 2; ++t) { const int tl = tl0 + t, mi = tl >> 2, vi = tl & 3; f32x4 acc = {0.f, 0.f, 0.f, 0.f};
#pragma unroll
                for (int ks = 0; ks < 2; ++ks) { acc = __builtin_amdgcn_mfma_f32_16x16x32_bf16(lds_frag(SC, 16 * mi + fr, 32 * ks + 8 * fq), lds_frag(VT, 16 * vi + fr, 32 * ks + 8 * fq), acc, 0, 0, 0);
                    acc = __builtin_amdgcn_mfma_f32_16x16x32_bf16(lds_frag(QI, 16 * mi + fr, 32 * ks + 8 * fq), lds_frag(ST, 16 * vi + fr, 32 * ks + 8 * fq), acc, 0, 0, 0); }
#pragma unroll
                for (int r = 0; r < 4; ++r) OT[(16 * mi + 4 * fq + r) * GLD + 16 * vi + fr] = (bf16)f2bf(acc[r]); }
        }
        __syncthreads(); GP_T(6);
        if (is_lat) *(v4u*)(O + ((size_t)dir * M_LAT + base + (dir ? 63 - pl : pl)) * 512 + 128 * g + 64 * vh + 8 * g8) = *(const LAS v4u*)(OT + pl * GLD + 8 * g8);
#pragma unroll
        for (int t = 0; t < 2; ++t) { const int tl = tl0 + t, ci = tl >> 2, vi = tl & 3;
            f32x4 acc = Sacc[t];
            const f32x4 dk = *(const LAS f32x4*)(BL + 16 * ci + 4 * fq);
            acc = acc * dk;
#pragma unroll
            for (int ks = 0; ks < 2; ++ks) acc = __builtin_amdgcn_mfma_f32_16x16x32_bf16(lds_frag(KOT, 16 * ci + fr, 32 * ks + 8 * fq), lds_frag(VT, 16 * vi + fr, 32 * ks + 8 * fq), acc, 0, 0, 0);
            Sacc[t] = acc;
            *(LAS v2u*)(ST + (16 * vi + fr) * GLD + 16 * ci + 4 * fq) = (v2u){pk2(acc[0], acc[1]), pk2(acc[2], acc[3])}; }
        if (SIDEJOB == 2) { }
        GP_T(7);
    }
    if (PROBE_GLA != 0) { const unsigned it_ = (unsigned)(gp_sum >> 6); for (unsigned i_ = 0; i_ < it_; ++i_) __builtin_amdgcn_s_sleep(1); }
#undef GLA_ISSUE
#undef GLA_BASE
    __syncthreads();
}

constexpr int ALD = 104;
constexpr int GOLD = 516;
__device__ __forceinline__ void mix_phase(Frame& F) {
    LAS float* GO = (LAS float*)F.lds;
    LAS bf16* AI = (LAS bf16*)(GO + 32 * GOLD);
    const bf16* Z = WSP(bf16, WS_Z); const bf16* Y = (const bf16*)F.out; const bf16* O = WSP(bf16, WS_O); const float* CB = WSP(float, WS_CB);
    const bf16* G2T = WSP(bf16, WS_G2T); bf16* MIX = WSP(bf16, WS_MIX);
    const int tid = F.tid, lane = F.lane, wv = F.wave, fr = lane & 15, fq = lane >> 4;
    const int col = 8 * lane, hh = lane >> 3, vcol = C_V + col;
    const int s1i = tid / 12, s1cgp = tid % 12, s1col = C_GD + 8 * (tid < 32 * 12 ? s1cgp : 0);
    float mu8[8], gnw[8], gnb[8], glw[8];
#pragma unroll
    for (int e = 0; e < 8; ++e) { mu8[e] = F.in[I_MU][vcol - MU_SHIFT + e]; gnw[e] = F.in[I_GNW][col + e]; gnb[e] = F.in[I_GNB][col + e]; glw[e] = F.in[I_GLNW][col + e]; }
    v4u ny[2], no[2]; v4u npc, npn[4], ngg; float ncb0, ncb1;
#define MIX_LOAD(ti_) do { const int row_ = row00 + 4 * wv + (ti_); const Nbr nnb_ = nbr_of(row_); \
        ny[0] = *(const v4u*)(Y + (size_t)row_ * 512 + col); ny[1] = *(const v4u*)(Y + ((size_t)M_LAT + row_) * 512 + col); \
        no[0] = *(const v4u*)(O + (size_t)row_ * 512 + col); no[1] = *(const v4u*)(O + ((size_t)M_LAT + row_) * 512 + col); \
        ncb0 = CB[(size_t)row_ * 8 + hh]; ncb1 = CB[((size_t)M_LAT + row_) * 8 + hh]; \
        npc = *(const v4u*)(Z + (size_t)row_ * INW + vcol); _Pragma("unroll") for (int q_ = 0; q_ < 4; ++q_) npn[q_] = *(const v4u*)(Z + (size_t)nnb_.r[q_] * INW + vcol); \
        ngg = *(const v4u*)(Z + (size_t)row_ * INW + C_GG + col); } while (0)
  for (int unit = F.bid; unit < M_LAT / 32; unit += F.G) {
    const int row00 = unit * 32;
    __syncthreads();
    MIX_LOAD(0);
    if (tid < 32 * 12) { const int i = s1i, cgp = s1cgp, row = row00 + i, col = C_GD + 8 * cgp; const Nbr nb = nbr_of(row);
        const v4u pc = *(const v4u*)(Z + (size_t)row * INW + col); v4u pn[4];
#pragma unroll
        for (int q = 0; q < 4; ++q) pn[q] = *(const v4u*)(Z + (size_t)nb.r[q] * INW + col);
        float zs[8], mu8g[8];
#pragma unroll
        for (int e = 0; e < 8; ++e) mu8g[e] = F.in[I_MU][s1col - MU_SHIFT + e];
        shift8(pc, pn, nb, mu8g, zs);
#pragma unroll
        for (int e = 0; e < 8; ++e) zs[e] = fsigmoid(zs[e]);
        *(LAS v4u*)(AI + i * ALD + 8 * cgp) = (v4u){pk2(zs[0], zs[1]), pk2(zs[2], zs[3]), pk2(zs[4], zs[5]), pk2(zs[6], zs[7])}; }
    __syncthreads();
    {
        bf16x8 af[2][3];
#pragma unroll
        for (int m = 0; m < 2; ++m)
#pragma unroll
            for (int ks = 0; ks < 3; ++ks) af[m][ks] = *(const LAS bf16x8*)(AI + (16 * m + fr) * ALD + 32 * ks + 8 * fq);
#pragma unroll
        for (int nn = 0; nn < 4; ++nn) { const int colb = 64 * wv + 16 * nn;
            bf16x8 bfg[3];
#pragma unroll
            for (int ks = 0; ks < 3; ++ks) bfg[ks] = *(const bf16x8*)(G2T + (size_t)(colb + fr) * 96 + 32 * ks + 8 * fq);
#pragma unroll
            for (int m = 0; m < 2; ++m) { f32x4 acc = {0.f, 0.f, 0.f, 0.f};
#pragma unroll
                for (int ks = 0; ks < 3; ++ks) acc = __builtin_amdgcn_mfma_f32_16x16x32_bf16(af[m][ks], bfg[ks], acc, 0, 0, 0);
#pragma unroll
                for (int r = 0; r < 4; ++r) GO[(16 * m + 4 * fq + r) * GOLD + colb + fr] = acc[r]; } }
    }
    __syncthreads();
    {
#pragma unroll
      for (int ti = 0; ti < 4; ++ti) { const int i = 4 * wv + ti, row = row00 + i;
        float yf[8], yb_[8], of[8], ob_[8]; unpack8(ny[0], yf); unpack8(ny[1], yb_); unpack8(no[0], of); unpack8(no[1], ob_);
        const v4u pc = npc, gw4 = ngg; v4u pn[4]; const Nbr nb = nbr_of(row); const float cb = ncb0 + ncb1;
#pragma unroll
        for (int q = 0; q < 4; ++q) pn[q] = npn[q];
        if (ti < 3) MIX_LOAD(ti + 1);
        { float y[8];
#pragma unroll
          for (int e = 0; e < 8; ++e) y[e] = yf[e] + yb_[e];
          float sm = 0.f;
#pragma unroll
          for (int e = 0; e < 8; ++e) sm += y[e];
          const float mean = red8(sm) * (1.0f / 64.0f); float s2 = 0.f;
#pragma unroll
          for (int e = 0; e < 8; ++e) { y[e] -= mean; s2 += y[e] * y[e]; }
          const float rstd = __builtin_amdgcn_rsqf(red8(s2) * (1.0f / 64.0f) + GN_EPS);
          float vs[8], o[8]; shift8(pc, pn, nb, mu8, vs);
          const f32x4 g0 = *(const LAS f32x4*)(GO + i * GOLD + col), g1 = *(const LAS f32x4*)(GO + i * GOLD + col + 4);
          const float go[8] = {g0.x, g0.y, g0.z, g0.w, g1.x, g1.y, g1.z, g1.w};
#pragma unroll
          for (int e = 0; e < 8; ++e) o[e] = (y[e] * rstd * gnw[e] + gnb[e] + cb * vs[e]) * go[e];
#if OUTPROJ_F8
          { float q_[8];
#pragma unroll
            for (int e = 0; e < 8; ++e) q_[e] = clamp448f(o[e] * MIX_SCALE);
            *(v2u*)((unsigned char*)MIX + (size_t)row * D + col) = (v2u){pk4_fp8(q_[0], q_[1], q_[2], q_[3]), pk4_fp8(q_[4], q_[5], q_[6], q_[7])}; } }
#else
          *(v4u*)(MIX + (size_t)row * D + col) = (v4u){pk2(o[0], o[1]), pk2(o[2], o[3]), pk2(o[4], o[5]), pk2(o[6], o[7])}; }
#endif
        { float o[8];
#pragma unroll
          for (int e = 0; e < 8; ++e) o[e] = of[e] + ob_[e];
          float s2 = 0.f;
#pragma unroll
          for (int e = 0; e < 8; ++e) s2 += o[e] * o[e];
          const float rs = __builtin_amdgcn_rsqf(red16(s2) * (1.0f / 128.0f) + GLA_EPS);
          float gg[8]; unpack8(gw4, gg);
#pragma unroll
          for (int e = 0; e < 8; ++e) o[e] = o[e] * rs * glw[e] * (gg[e] * fsigmoid(gg[e]));
#if OUTPROJ_F8
          { float q_[8];
#pragma unroll
            for (int e = 0; e < 8; ++e) q_[e] = clamp448f(o[e] * MIX_SCALE);
            *(v2u*)((unsigned char*)MIX + (size_t)row * D + 512 + col) = (v2u){pk4_fp8(q_[0], q_[1], q_[2], q_[3]), pk4_fp8(q_[4], q_[5], q_[6], q_[7])}; } }
#else
          *(v4u*)(MIX + (size_t)row * D + 512 + col) = (v4u){pk2(o[0], o[1]), pk2(o[2], o[3]), pk2(o[4], o[5]), pk2(o[6], o[7])}; }
#endif
      }
    }
  }
#undef MIX_LOAD
    __syncthreads();
}

#ifndef P7_TREDUCE
#define P7_TREDUCE 1
#endif
constexpr int RWLD = 1028;
__device__ __forceinline__ void p7_ln_router(Frame& F) {
    const int gw = F.bid * NWAVES + F.wave, NGW = F.G * NWAVES;
    const float* mod = WSP(float, WS_MOD); const bf16* PROJ = WSP(bf16, WS_PROJ); unsigned char* H2 = WSP(unsigned char, WS_H2); float* AFF = WSP(float, WS_AFF);
    LAS float* RWT = (LAS float*)F.lds;
    __syncthreads();
    for (int i = F.tid; i < D * NE; i += NTHR) RWT[(i & 15) * RWLD + (i >> 4)] = F.in[I_RTW][i];
    __syncthreads();
    f32x4 lgv[4], lbv[4];
#pragma unroll
    for (int j = 0; j < 4; ++j) { lgv[j] = ((const f32x4*)F.in[I_LN1G] + F.lane)[64 * j]; lbv[j] = ((const f32x4*)F.in[I_LN1B] + F.lane)[64 * j]; }
    f32x4 nx[4]; v2u np_[4];
    if (gw < M_LAT) { const f32x4* xr = (const f32x4*)(F.in[I_X] + (size_t)gw * D) + F.lane; const v2u* pr = (const v2u*)(PROJ + (size_t)gw * D) + F.lane;
#pragma unroll
        for (int j = 0; j < 4; ++j) { nx[j] = xr[64 * j]; np_[j] = pr[64 * j]; } }
    if (NGW == 2048) {
        const int b = gw >> 7, m0 = (b << 11) + 16 * (gw & 127), mlast = m0 + 16; const float* mrow = mod + (size_t)b * 6 * D;
        f32x4 g1v[4], shv[4], scv[4];
#pragma unroll
        for (int j = 0; j < 4; ++j) { g1v[j] = ((const f32x4*)(mrow + 2 * D) + F.lane)[64 * j]; shv[j] = ((const f32x4*)(mrow + 3 * D) + F.lane)[64 * j]; scv[j] = ((const f32x4*)(mrow + 4 * D) + F.lane)[64 * j]; }
        { const f32x4* xr = (const f32x4*)(F.in[I_X] + (size_t)m0 * D) + F.lane; const v2u* pr = (const v2u*)(PROJ + (size_t)m0 * D) + F.lane;
#pragma unroll
          for (int j = 0; j < 4; ++j) { nx[j] = xr[64 * j]; np_[j] = pr[64 * j]; } }
        for (int m = m0; m < mlast; ++m) {
        f32x4 v[4]; float s = 0.f;
#pragma unroll
        for (int j = 0; j < 4; ++j) { const f32x4 pj = {bflo(np_[j].x), bfhi(np_[j].x), bflo(np_[j].y), bfhi(np_[j].y)}; v[j] = nx[j] * DN_ALPHA + g1v[j] * pj; s += (v[j].x + v[j].y) + (v[j].z + v[j].w); }
        { const int mn = (m + 1 < mlast) ? m + 1 : m;
          const f32x4* xr = (const f32x4*)(F.in[I_X] + (size_t)mn * D) + F.lane; const v2u* pr = (const v2u*)(PROJ + (size_t)mn * D) + F.lane;
#pragma unroll
          for (int j = 0; j < 4; ++j) { nx[j] = xr[64 * j]; np_[j] = pr[64 * j]; } }
        float mean = wave_sum_dpp(s) * (1.f / D); float s2 = 0.f;
#pragma unroll
        for (int j = 0; j < 4; ++j) { v[j] = v[j] - mean; s2 += (v[j].x * v[j].x + v[j].y * v[j].y) + (v[j].z * v[j].z + v[j].w * v[j].w); }
        float rstd = __builtin_amdgcn_rsqf(wave_sum_dpp(s2) * (1.f / D) + LN_EPS);
        unsigned long long* x1 = (unsigned long long*)(WSP(bf16, WS_X1) + (size_t)m * D) + F.lane;
        s = 0.f;
#pragma unroll
        for (int j = 0; j < 4; ++j) { v[j] = v[j] * rstd * lgv[j] + lbv[j]; x1[64 * j] = (unsigned long long)pk2(v[j].x, v[j].y) | ((unsigned long long)pk2(v[j].z, v[j].w) << 32); s += (v[j].x + v[j].y) + (v[j].z + v[j].w); }
        mean = wave_sum_dpp(s) * (1.f / D); s2 = 0.f;
#pragma unroll
        for (int j = 0; j < 4; ++j) { v[j] = v[j] - mean; s2 += (v[j].x * v[j].x + v[j].y * v[j].y) + (v[j].z * v[j].z + v[j].w * v[j].w); }
        rstd = __builtin_amdgcn_rsqf(wave_sum_dpp(s2) * (1.f / D) + LN_EPS);
        unsigned* o4 = (unsigned*)(H2 + (size_t)m * D) + F.lane;
        float lg16[16];
#pragma unroll
        for (int j = 0; j < 4; ++j) { v[j] = v[j] * rstd * (scv[j] + 1.0f) + shv[j];
            o4[64 * j] = pk4_fp8(v[j].x * XIN_L, v[j].y * XIN_L, v[j].z * XIN_L, v[j].w * XIN_L); }
#pragma unroll
        for (int e = 0; e < 16; ++e) { float a = 0.f;
#pragma unroll
            for (int j = 0; j < 4; ++j) { const f32x4 w = *(const LAS f32x4*)(RWT + e * RWLD + 256 * j + 4 * F.lane);
                a = __builtin_fmaf(v[j].x, w.x, a); a = __builtin_fmaf(v[j].y, w.y, a); a = __builtin_fmaf(v[j].z, w.z, a); a = __builtin_fmaf(v[j].w, w.w, a); }
            lg16[e] = a;
            if ((e & 3) == 3) __builtin_amdgcn_sched_barrier(0); }
#if P7_TREDUCE
        float x8[8], y4[4], z2[2];
#pragma unroll
        for (int i = 0; i < 8; ++i) { const auto r = __builtin_amdgcn_permlane32_swap(__builtin_bit_cast(int, lg16[i]), __builtin_bit_cast(int, lg16[i + 8]), false, false);
            const int r0 = r[0], r1 = r[1]; x8[i] = __builtin_bit_cast(float, r0) + __builtin_bit_cast(float, r1); }
#pragma unroll
        for (int i = 0; i < 4; ++i) { const auto r = __builtin_amdgcn_permlane16_swap(__builtin_bit_cast(int, x8[i]), __builtin_bit_cast(int, x8[i + 4]), false, false);
            const int r0 = r[0], r1 = r[1]; y4[i] = __builtin_bit_cast(float, r0) + __builtin_bit_cast(float, r1); }
        const bool b3 = (F.lane & 8) != 0, b2 = (F.lane & 4) != 0;
#pragma unroll
        for (int i = 0; i < 2; ++i) { const float t = b3 ? y4[i + 2] : y4[i], u = b3 ? y4[i] : y4[i + 2]; z2[i] = t + dppmov<0x128>(u); }
        float mine; { const float t = b2 ? z2[1] : z2[0], u = b2 ? z2[0] : z2[1]; mine = t + dppmov<0x141>(u); }
        mine += dppmov<0xB1>(mine); mine += dppmov<0x4E>(mine);
        float mx = fmaxf(mine, dppmov<0x141>(mine)); mx = fmaxf(mx, dppmov<0x140>(mx));
        { const auto r = __builtin_amdgcn_permlane16_swap(__builtin_bit_cast(int, mx), __builtin_bit_cast(int, mx), false, false); const int r0 = r[0], r1 = r[1]; mx = fmaxf(__builtin_bit_cast(float, r0), __builtin_bit_cast(float, r1)); }
        { const auto r = __builtin_amdgcn_permlane32_swap(__builtin_bit_cast(int, mx), __builtin_bit_cast(int, mx), false, false); const int r0 = r[0], r1 = r[1]; mx = fmaxf(__builtin_bit_cast(float, r0), __builtin_bit_cast(float, r1)); }
        const float ex = fexp(mine - mx), den = wave_sum_dpp(ex) * 0.25f;
        if ((F.lane & 3) == 0) AFF[(size_t)m * NE + (F.lane >> 2)] = ex * __builtin_amdgcn_rcpf(den);
#else
        float mx = -1e30f;
#pragma unroll
        for (int e = 0; e < 16; ++e) { lg16[e] = wave_sum_dpp(lg16[e]); mx = fmaxf(mx, lg16[e]); }
        float mine = 0.f;
#pragma unroll
        for (int e = 0; e < 16; ++e) mine = (F.lane == e) ? lg16[e] : mine;
        const float ex = fexp(mine - mx), den = row_total16(ex);
        if (F.lane < 16) AFF[(size_t)m * NE + F.lane] = ex * __builtin_amdgcn_rcpf(den);
#endif
    }
    } else {
        for (int m = gw; m < M_LAT; m += NGW) {
            const int b = m >> 11; const float* mrow = mod + (size_t)b * 6 * D;
            f32x4 g1v[4], shv[4], scv[4];
    #pragma unroll
            for (int j = 0; j < 4; ++j) { g1v[j] = ((const f32x4*)(mrow + 2 * D) + F.lane)[64 * j]; shv[j] = ((const f32x4*)(mrow + 3 * D) + F.lane)[64 * j]; scv[j] = ((const f32x4*)(mrow + 4 * D) + F.lane)[64 * j]; }
            f32x4 v[4]; float s = 0.f;
    #pragma unroll
            for (int j = 0; j < 4; ++j) { const f32x4 pj = {bflo(np_[j].x), bfhi(np_[j].x), bflo(np_[j].y), bfhi(np_[j].y)}; v[j] = nx[j] * DN_ALPHA + g1v[j] * pj; s += (v[j].x + v[j].y) + (v[j].z + v[j].w); }
            { const int mn = (m + NGW < M_LAT) ? m + NGW : m;
              const f32x4* xr = (const f32x4*)(F.in[I_X] + (size_t)mn * D) + F.lane; const v2u* pr = (const v2u*)(PROJ + (size_t)mn * D) + F.lane;
    #pragma unroll
              for (int j = 0; j < 4; ++j) { nx[j] = xr[64 * j]; np_[j] = pr[64 * j]; } }
            float mean = wave_sum_dpp(s) * (1.f / D); float s2 = 0.f;
    #pragma unroll
            for (int j = 0; j < 4; ++j) { v[j] = v[j] - mean; s2 += (v[j].x * v[j].x + v[j].y * v[j].y) + (v[j].z * v[j].z + v[j].w * v[j].w); }
            float rstd = __builtin_amdgcn_rsqf(wave_sum_dpp(s2) * (1.f / D) + LN_EPS);
            unsigned long long* x1 = (unsigned long long*)(WSP(bf16, WS_X1) + (size_t)m * D) + F.lane;
            s = 0.f;
    #pragma unroll
            for (int j = 0; j < 4; ++j) { v[j] = v[j] * rstd * lgv[j] + lbv[j]; x1[64 * j] = (unsigned long long)pk2(v[j].x, v[j].y) | ((unsigned long long)pk2(v[j].z, v[j].w) << 32); s += (v[j].x + v[j].y) + (v[j].z + v[j].w); }
            mean = wave_sum_dpp(s) * (1.f / D); s2 = 0.f;
    #pragma unroll
            for (int j = 0; j < 4; ++j) { v[j] = v[j] - mean; s2 += (v[j].x * v[j].x + v[j].y * v[j].y) + (v[j].z * v[j].z + v[j].w * v[j].w); }
            rstd = __builtin_amdgcn_rsqf(wave_sum_dpp(s2) * (1.f / D) + LN_EPS);
            unsigned* o4 = (unsigned*)(H2 + (size_t)m * D) + F.lane;
            float lg16[16];
    #pragma unroll
            for (int j = 0; j < 4; ++j) { v[j] = v[j] * rstd * (scv[j] + 1.0f) + shv[j];
                o4[64 * j] = pk4_fp8(v[j].x * XIN_L, v[j].y * XIN_L, v[j].z * XIN_L, v[j].w * XIN_L); }
    #pragma unroll
            for (int e = 0; e < 16; ++e) { float a = 0.f;
    #pragma unroll
                for (int j = 0; j < 4; ++j) { const f32x4 w = *(const LAS f32x4*)(RWT + e * RWLD + 256 * j + 4 * F.lane);
                    a = __builtin_fmaf(v[j].x, w.x, a); a = __builtin_fmaf(v[j].y, w.y, a); a = __builtin_fmaf(v[j].z, w.z, a); a = __builtin_fmaf(v[j].w, w.w, a); }
                lg16[e] = a;
                if ((e & 3) == 3) __builtin_amdgcn_sched_barrier(0); }
    #if P7_TREDUCE
            float x8[8], y4[4], z2[2];
    #pragma unroll
            for (int i = 0; i < 8; ++i) { const auto r = __builtin_amdgcn_permlane32_swap(__builtin_bit_cast(int, lg16[i]), __builtin_bit_cast(int, lg16[i + 8]), false, false);
                const int r0 = r[0], r1 = r[1]; x8[i] = __builtin_bit_cast(float, r0) + __builtin_bit_cast(float, r1); }
    #pragma unroll
            for (int i = 0; i < 4; ++i) { const auto r = __builtin_amdgcn_permlane16_swap(__builtin_bit_cast(int, x8[i]), __builtin_bit_cast(int, x8[i + 4]), false, false);
                const int r0 = r[0], r1 = r[1]; y4[i] = __builtin_bit_cast(float, r0) + __builtin_bit_cast(float, r1); }
            const bool b3 = (F.lane & 8) != 0, b2 = (F.lane & 4) != 0;
    #pragma unroll
            for (int i = 0; i < 2; ++i) { const float t = b3 ? y4[i + 2] : y4[i], u = b3 ? y4[i] : y4[i + 2]; z2[i] = t + dppmov<0x128>(u); }
            float mine; { const float t = b2 ? z2[1] : z2[0], u = b2 ? z2[0] : z2[1]; mine = t + dppmov<0x141>(u); }
            mine += dppmov<0xB1>(mine); mine += dppmov<0x4E>(mine);
            float mx = fmaxf(mine, dppmov<0x141>(mine)); mx = fmaxf(mx, dppmov<0x140>(mx));
            { const auto r = __builtin_amdgcn_permlane16_swap(__builtin_bit_cast(int, mx), __builtin_bit_cast(int, mx), false, false); const int r0 = r[0], r1 = r[1]; mx = fmaxf(__builtin_bit_cast(float, r0), __builtin_bit_cast(float, r1)); }
            { const auto r = __builtin_amdgcn_permlane32_swap(__builtin_bit_cast(int, mx), __builtin_bit_cast(int, mx), false, false); const int r0 = r[0], r1 = r[1]; mx = fmaxf(__builtin_bit_cast(float, r0), __builtin_bit_cast(float, r1)); }
            const float ex = fexp(mine - mx), den = wave_sum_dpp(ex) * 0.25f;
            if ((F.lane & 3) == 0) AFF[(size_t)m * NE + (F.lane >> 2)] = ex * __builtin_amdgcn_rcpf(den);
    #else
            float mx = -1e30f;
    #pragma unroll
            for (int e = 0; e < 16; ++e) { lg16[e] = wave_sum_dpp(lg16[e]); mx = fmaxf(mx, lg16[e]); }
            float mine = 0.f;
    #pragma unroll
            for (int e = 0; e < 16; ++e) mine = (F.lane == e) ? lg16[e] : mine;
            const float ex = fexp(mine - mx), den = row_total16(ex);
            if (F.lane < 16) AFF[(size_t)m * NE + F.lane] = ex * __builtin_amdgcn_rcpf(den);
    #endif
        }
    }
    __syncthreads();
}

__device__ __forceinline__ void p8_topk_unit(Frame& F, int unit) {
    const int b = unit >> 4, e = unit & 15;
    LAS unsigned long long* KEY = (LAS unsigned long long*)F.lds;
    const float* AFF = WSP(float, WS_AFF); int* SELPOS = WSP(int, WS_SELPOS); float* GATE = WSP(float, WS_GATE);
    const unsigned char* H2 = WSP(unsigned char, WS_H2); unsigned char* XIN = WSP(unsigned char, WS_XIN);
    const int tid = F.tid;
    __syncthreads();
    { float av[T / NTHR];
#pragma unroll
      for (int q = 0; q < T / NTHR; ++q) av[q] = AFF[((size_t)b * T + tid + NTHR * q) * NE + e];
#pragma unroll
      for (int q = 0; q < T / NTHR; ++q) { const int t = tid + NTHR * q; KEY[t] = ((unsigned long long)__builtin_bit_cast(unsigned, av[q]) << 32) | (unsigned long long)(0xFFFFFFFFu - (unsigned)t); } }
    __syncthreads();
    for (int k = 2; k <= T; k <<= 1)
        for (int j = k >> 1; j > 0; j >>= 1) {
#pragma unroll
            for (int q = 0; q < 2; ++q) { const int pi = tid + NTHR * q; const int i = ((pi & ~(j - 1)) << 1) | (pi & (j - 1)), l = i | j;
                const unsigned long long x = KEY[i], y = KEY[l]; const bool desc = (i & k) == 0;
                if (desc ? (x < y) : (x > y)) { KEY[i] = y; KEY[l] = x; } }
            __syncthreads();
        }
    for (int p = tid; p < T; p += NTHR) { const unsigned long long kv = KEY[p]; const int t = (int)(0xFFFFFFFFu - (unsigned)(kv & 0xFFFFFFFFull));
        SELPOS[((size_t)b * NE + e) * T + t] = p < CAP ? p : -1;
        if (p < CAP) GATE[((size_t)b * NE + e) * CAP + p] = __builtin_bit_cast(float, (unsigned)(kv >> 32)); }
    { v4u rowv[CAP / NWAVES];
#pragma unroll
      for (int u = 0; u < CAP / NWAVES; ++u) { const int p = F.wave * (CAP / NWAVES) + u; const unsigned long long kv = KEY[p]; const int t = (int)(0xFFFFFFFFu - (unsigned)(kv & 0xFFFFFFFFull));
          rowv[u] = *((const v4u*)(H2 + ((size_t)b * T + t) * D) + F.lane); }
#pragma unroll
      for (int u = 0; u < CAP / NWAVES; ++u) { const int p = F.wave * (CAP / NWAVES) + u; *((v4u*)(XIN + ((size_t)e * (NB * CAP) + b * CAP + p) * D) + F.lane) = rowv[u]; } }
    __syncthreads();
}

struct P11Slots { float g[4]; unsigned y[4][4]; };
__device__ __forceinline__ unsigned long long p11_mask(int pv) { return __builtin_amdgcn_ballot_w64(pv >= 0) & 0xffffull; }
__device__ __forceinline__ void p11_issue(Frame& F, int m, int pv, unsigned long long mask, P11Slots& S) {
    const float* GATE = WSP(float, WS_GATE); const unsigned char* YE = WSP(unsigned char, WS_YE); const int b = m >> 11;
#pragma unroll
    for (int i = 0; i < 4; ++i) { const int e16 = (int)__builtin_ctzll(mask | 0x10000ull); const bool on = e16 < 16; const int e = e16 & 15; mask &= mask - 1ull;
        const int pl_ = __builtin_amdgcn_readlane(pv, e); const int pos = on ? pl_ : 0;
        const float gt = GATE[((size_t)b * NE + e) * CAP + pos]; S.g[i] = on ? gt * (1.0f / YE_SCALE) : 0.f;
        const unsigned* yr = (const unsigned*)(YE + ((size_t)e * (NB * CAP) + b * CAP + pos) * D) + F.lane;
#pragma unroll
        for (int j = 0; j < 4; ++j) S.y[i][j] = yr[64 * j]; }
}
__device__ __forceinline__ void p11_final(Frame& F) {
    const int gw = F.bid * NWAVES + F.wave, NGW = F.G * NWAVES;
    const float* mod = WSP(float, WS_MOD); const int* SELPOS = WSP(int, WS_SELPOS); const float* GATE = WSP(float, WS_GATE); const unsigned char* YE = WSP(unsigned char, WS_YE); const bf16* X1 = WSP(bf16, WS_X1);
    const f32x4* lg = (const f32x4*)F.in[I_LN2G] + F.lane; const f32x4* lb = (const f32x4*)F.in[I_LN2B] + F.lane;
    const int le = F.lane & 15;
    auto p11_pos = [&](int m_) -> int { const int mm = m_ < M_LAT ? m_ : M_LAT - 1;
        const int val = SELPOS[((size_t)(mm >> 11) * NE + le) * T + (mm & (T - 1))]; return (F.lane < 16 && m_ < M_LAT) ? val : -1; };
#define P11_POS(m_) p11_pos(m_)
    f32x4 lgv[4], lbv[4];
#pragma unroll
    for (int j = 0; j < 4; ++j) { lgv[j] = lg[64 * j]; lbv[j] = lb[64 * j]; }
    v2u nx[4]; P11Slots ns; int pv_cur = -1, pv_next = -1;
    if (gw < M_LAT) { const v2u* xr = (const v2u*)(X1 + (size_t)gw * D) + F.lane;
#pragma unroll
        for (int j = 0; j < 4; ++j) nx[j] = xr[64 * j];
        pv_cur = P11_POS(gw); pv_next = P11_POS(gw + NGW);
        p11_issue(F, gw, pv_cur, p11_mask(pv_cur), ns); }
    for (int m = gw; m < M_LAT; m += NGW) {
        const int b = m >> 11; const float* mrow = mod + (size_t)b * 6 * D;
        f32x4 xv[4]; P11Slots cs; const int pv = pv_cur; unsigned long long mask = p11_mask(pv);
#pragma unroll
        for (int j = 0; j < 4; ++j) xv[j] = (f32x4){bflo(nx[j].x), bfhi(nx[j].x), bflo(nx[j].y), bfhi(nx[j].y)};
#pragma unroll
        for (int i = 0; i < 4; ++i) { cs.g[i] = ns.g[i];
#pragma unroll
            for (int j = 0; j < 4; ++j) cs.y[i][j] = ns.y[i][j]; }
        f32x4 g2v[4];
#pragma unroll
        for (int j = 0; j < 4; ++j) g2v[j] = ((const f32x4*)(mrow + 5 * D) + F.lane)[64 * j];
        { const bool more = m + NGW < M_LAT; const int m2 = more ? m + NGW : m; const v2u* xr = (const v2u*)(X1 + (size_t)m2 * D) + F.lane;
#pragma unroll
            for (int j = 0; j < 4; ++j) nx[j] = xr[64 * j];
            pv_cur = pv_next; p11_issue(F, m2, pv_cur, p11_mask(pv_cur), ns); pv_next = P11_POS(more ? m2 + NGW : M_LAT); }
        f32x4 acc[4];
#pragma unroll
        for (int j = 0; j < 4; ++j) acc[j] = (f32x4){0.f, 0.f, 0.f, 0.f};
#pragma unroll
        for (int i = 0; i < 4; ++i) {
#pragma unroll
            for (int j = 0; j < 4; ++j) { float f[4]; unpack4_fp8(cs.y[i][j], f); acc[j].x += cs.g[i] * f[0]; acc[j].y += cs.g[i] * f[1]; acc[j].z += cs.g[i] * f[2]; acc[j].w += cs.g[i] * f[3]; } }
        f32x4 v[4];
#pragma unroll
        for (int j = 0; j < 4; ++j) v[j] = xv[j] * DN_ALPHA + g2v[j] * acc[j];
        { unsigned long long rest = mask;
#pragma unroll
          for (int i = 0; i < 4; ++i) rest &= rest - 1ull;
          while (rest != 0ull) { const int e = (int)__builtin_ctzll(rest); rest &= rest - 1ull; const int pos = __builtin_amdgcn_readlane(pv, e);
              const float gt = GATE[((size_t)b * NE + e) * CAP + pos] * (1.0f / YE_SCALE);
              const unsigned* yr = (const unsigned*)(YE + ((size_t)e * (NB * CAP) + b * CAP + pos) * D) + F.lane;
#pragma unroll
              for (int j = 0; j < 4; ++j) { float f[4]; unpack4_fp8(yr[64 * j], f); const f32x4 gg = g2v[j] * gt; v[j].x += gg.x * f[0]; v[j].y += gg.y * f[1]; v[j].z += gg.z * f[2]; v[j].w += gg.w * f[3]; } } }
        f32x4* x1 = (f32x4*)(F.out + (size_t)m * D) + F.lane;
        float s = 0.f;
#pragma unroll
        for (int j = 0; j < 4; ++j) s += (v[j].x + v[j].y) + (v[j].z + v[j].w);
        const float mean = wave_sum_dpp(s) * (1.f / D); float s2 = 0.f;
#pragma unroll
        for (int j = 0; j < 4; ++j) { v[j] = v[j] - mean; s2 += (v[j].x * v[j].x + v[j].y * v[j].y) + (v[j].z * v[j].z + v[j].w * v[j].w); }
        const float rstd = __builtin_amdgcn_rsqf(wave_sum_dpp(s2) * (1.f / D) + LN_EPS);
#pragma unroll
        for (int j = 0; j < 4; ++j) x1[64 * j] = v[j] * rstd * lgv[j] + lbv[j];
    }
#undef P11_POS
}

constexpr int N_PHASES = 12;
__global__ void __launch_bounds__(NTHR, 2) fwd_kernel(Args args) {
    extern __shared__ __attribute__((aligned(16))) unsigned char lds[];
    Frame F;
    F.lds = (LAS unsigned char*)lds;
    F.tid = threadIdx.x; F.lane = F.tid & 63; F.wave = __builtin_amdgcn_readfirstlane(F.tid >> 6);
    F.G = gridDim.x; F.bid = blockIdx.x;
    F.in = args.in; F.out = args.out; F.ws = args.ws;
    volatile LAS unsigned* MISC = (volatile LAS unsigned*)(F.lds + MISC_OFF);
    for (int u = F.tid; u < (LDS_BYTES - LDSCTL_OFF) / 4; u += NTHR) ((LAS unsigned*)(F.lds + LDSCTL_OFF))[u] = 0u;
    __syncthreads();
    const int lo = args.ph_lo, hi = args.ph_hi;
    const bool multi = (hi - lo) > 1;
    XcdBarrier bar; bar.bar = (unsigned*)(F.ws + WS_CTL) + CW_BAR; bar.x = 0; bar.st = nullptr;
    if (multi) bar = xcd_barrier_post((unsigned*)(F.ws + WS_CTL) + CW_BAR, MISC + 8);
#ifndef PROBE_REP
#define PROBE_REP 0
#endif
#define IN(k) (lo <= (k) && (k) < hi)
#ifndef PROBE_REPN
#define PROBE_REPN 1
#endif
#define REP(k) for (int _r = 0; _r <= PROBE_REPN * ((PROBE_REP >> (k)) & 1); ++_r)
#define SEAM(k) do { if (IN(k) && IN((k) + 1)) xcd_barrier(bar); } while (0)
#ifndef GEMM1_ALIGN_EPI
#define GEMM1_ALIGN_EPI true
#endif
#ifndef PROBE_PHASE
#define PROBE_PHASE -1
#endif
    unsigned long long pp_t0 = 0, pp_sum = 0;
#define PP_BEG(k) do { if (PROBE_PHASE == (k)) pp_t0 = __builtin_readcyclecounter(); } while (0)
#define PP_END(k) do { if (PROBE_PHASE == (k)) pp_sum += __builtin_readcyclecounter() - pp_t0; } while (0)
    using namespace pg8;
    PP_BEG(0); PP_BEG(20); if (IN(0)) REP(0) { if (PROBE_PHASE == 20) { p0_prologue(F, 1); PP_END(20); p0_prologue(F, 2); } else p0_prologue(F); } PP_END(0); SEAM(0);
    PP_BEG(1); if (IN(1)) REP(1) { p1_ln_mod(F); } PP_END(1); SEAM(1);
#ifdef PROBE_BARRIERS
    for (int pb_ = 0; pb_ < PROBE_BARRIERS; ++pb_) xcd_barrier(bar);
#endif
    PP_BEG(2); if (IN(2)) REP(2) {
        Gemm g{WSP(bf16_t, WS_H0), WSP(bf16_t, WS_WIN), M_ALL, INW, D}; InProjOrder S; S.init(M_LAT, M_CTX, INW, 5, F.G, F.bid);
#if INPROJ_F8
        EpiBf16 E{WSP(bf16_t, WS_Z), INW, 1.0f / (HA_SCALE * WIN_SCALE)};
        gemm_phase<EpiBf16, InProjOrder, true>(F.lds, g, S, E);
#else
        EpiBf16 E{WSP(bf16_t, WS_Z), INW, 1.0f};
        gemm_phase<EpiBf16, InProjOrder>(F.lds, g, S, E);
#endif
    } PP_END(2); SEAM(2);
    PP_BEG(3); if (IN(3)) REP(3) { for (int u = F.bid; u < 256; u += F.G) scan_unit(F, u); } PP_END(3);
    PP_BEG(4); if (IN(4)) REP(4) { for (int u = F.bid; u < 256; u += F.G) gla_unit(F, u); } PP_END(4); SEAM(4);
    PP_BEG(5); if (IN(5)) REP(5) { mix_phase(F); } PP_END(5); SEAM(5);
    PP_BEG(6); if (IN(6)) REP(6) {
        Gemm g{WSP(bf16_t, WS_MIX), WSP(bf16_t, WS_WOUT), M_LAT, D, D}; StaticOrder S; S.init(M_LAT, D, F.G, F.bid);
#if OUTPROJ_F8
        static_assert(MIX_SCALE * WOUT_SCALE == 2048.0f, "the block scale 2^-11 undoes the operand scales");
        EpiBf16S11 E{{WSP(bf16_t, WS_PROJ), D, 1.0f}};
        gemm_phase<EpiBf16S11, StaticOrder, true>(F.lds, g, S, E);
#else
        EpiBf16 E{WSP(bf16_t, WS_PROJ), D, 1.0f};
        gemm_phase<EpiBf16, StaticOrder>(F.lds, g, S, E);
#endif
    } PP_END(6); SEAM(6);
    PP_BEG(7); if (IN(7)) REP(7) { p7_ln_router(F); } PP_END(7); SEAM(7);
    PP_BEG(8); if (IN(8)) REP(8) { for (int u = F.bid; u < NB * NE; u += F.G) p8_topk_unit(F, u); } PP_END(8); SEAM(8);
    PP_BEG(9); if (IN(9)) REP(9) {
        Gemm g{WSP(bf16_t, WS_XIN), WSP(bf16_t, WS_WGU), NE * NB * CAP, 2 * FF, D}; StaticOrder S; S.init(NE * NB * CAP, 2 * FF, F.G, F.bid, 16, 0);
        EpiSwiGLU8 E{WSP(unsigned char, WS_HH), FF, 1.0f / W1_SCALE, H_SCALE};
        gemm_phase<EpiSwiGLU8, StaticOrder, true, GEMM1_ALIGN_EPI>(F.lds, g, S, E);
    } PP_END(9); SEAM(9);
    PP_BEG(10); if (IN(10)) REP(10) {
        Gemm g{WSP(bf16_t, WS_HH), WSP(bf16_t, WS_WD), NE * NB * CAP, D, FF}; StaticOrder S; S.init(NE * NB * CAP, D, F.G, F.bid, 16, 0);
        EpiF8 E{WSP(unsigned char, WS_YE), D, 1.0f};
        gemm_phase<EpiF8, StaticOrder, true>(F.lds, g, S, E);
    } PP_END(10); SEAM(10);
    PP_BEG(11); if (IN(11)) REP(11) { p11_final(F); } PP_END(11);
    if (PROBE_PHASE >= 0) { __syncthreads(); const unsigned it_ = (unsigned)(pp_sum >> 6); for (unsigned i_ = 0; i_ < it_; ++i_) __builtin_amdgcn_s_sleep(1); }
#undef IN
#undef SEAM
}

extern "C" void kernel_launch(void* const* d_in, const int* in_sizes, int n_in, void* d_out, int out_size, void* d_ws, size_t ws_size, hipStream_t stream) {
    static int grid = 0;
    if (grid == 0) {
        if (n_in != N_IN || out_size != M_LAT * D || ws_size < WS_END) { fprintf(stderr, "kernel_launch: unexpected shapes (n_in %d, out %d, ws %zu)\n", n_in, out_size, ws_size); grid = -1; return; }
        int dev = 0, cus = 0;
        if (hipGetDevice(&dev) != hipSuccess || hipDeviceGetAttribute(&cus, hipDeviceAttributeMultiprocessorCount, dev) != hipSuccess) { grid = -1; return; }
        if (hipFuncSetAttribute((const void*)fwd_kernel, hipFuncAttributeMaxDynamicSharedMemorySize, LDS_BYTES) != hipSuccess) { fprintf(stderr, "kernel_launch: hipFuncSetAttribute failed\n"); grid = -1; return; }
        (void)hipGetLastError();
        grid = cus;
    }
    if (grid < 0) return;
    (void)hipMemsetAsync((char*)d_ws + WS_CTL, 0, CTL_ZERO_BYTES, stream);
    Args a{};
    for (int i = 0; i < N_IN; ++i) a.in[i] = (const float*)d_in[i];
    a.out = (float*)d_out; a.ws = (unsigned char*)d_ws;
#ifndef MK_ONE_LAUNCH
#define MK_ONE_LAUNCH 1
#endif
    if (MK_ONE_LAUNCH) { a.ph_lo = 0; a.ph_hi = N_PHASES; hipLaunchKernelGGL(fwd_kernel, dim3(grid), dim3(NTHR), LDS_BYTES, stream, a); }
    else {
        const int cuts[] = {0, 1, 2, 3, 5, 6, 7, 8, 9, 10, 11, 12};
        for (int li = 0; li + 1 < (int)(sizeof(cuts) / sizeof(cuts[0])); ++li) { a.ph_lo = cuts[li]; a.ph_hi = cuts[li + 1]; hipLaunchKernelGGL(fwd_kernel, dim3(grid), dim3(NTHR), LDS_BYTES, stream, a); }
    }
}
```
